# Optimizing an MI355X kernel written in HIP

```python
import jax, jax.numpy as jnp
from jax import lax
import numpy as np

D_MODEL = 1024
BATCH = 4
SEQ = 4096
DEPTH = 2
DEC_BATCH = 16
DEC_SEQ = 16
PAST_LEN = 2048

CHUNK = 64
N_MIXERS = 2
N_POOL_LAYERS = (DEPTH + 1) // 2
N_GLA_LAYERS = DEPTH // 2
POOL_WINDOWS = (2, 4, 8, 16)
N_POOL_GROUPS = len(POOL_WINDOWS)
POOL_GROUP = D_MODEL // N_POOL_GROUPS
POOL_HIST = max(POOL_WINDOWS) - 1
GLA_HEADS = 4
GLA_KEY_DIM = D_MODEL // 2
GLA_VAL_DIM = D_MODEL
GLA_DK = GLA_KEY_DIM // GLA_HEADS
GLA_DV = GLA_VAL_DIM // GLA_HEADS
GLA_GATE_RANK = 16
GLA_GATE_NORMALIZER = 16.0
GLA_IN = 2 * GLA_KEY_DIM + 2 * GLA_VAL_DIM + GLA_GATE_RANK
D_FF = -(-8 * D_MODEL // (3 * 256)) * 256
PLE_DIM = 256
EPS = 1e-6

kernel_name = "hybrid_pool_gla_streaming_step"


def rmsnorm(x, g):
    xf = x.astype(jnp.float32)
    y = xf * lax.rsqrt(jnp.mean(xf * xf, axis=-1, keepdims=True) + EPS)
    return (y * g.astype(jnp.float32)).astype(x.dtype)


def pool_mixer(xn, hist, start, w_pool, b_pool, scale):
    B, T, D = xn.shape
    full = jnp.concatenate([hist.astype(xn.dtype), xn], axis=1).astype(jnp.float32)
    csum = jnp.concatenate([jnp.zeros((B, 1, D), jnp.float32), jnp.cumsum(full, axis=1)], axis=1)
    pos = start + jnp.arange(T)
    diffs = []
    for gi, w in enumerate(POOL_WINDOWS):
        sl = slice(gi * POOL_GROUP, (gi + 1) * POOL_GROUP)
        hi = csum[:, POOL_HIST + 1:, sl]
        lo = csum[:, POOL_HIST + 1 - w:POOL_HIST + 1 - w + T, sl]
        cnt = jnp.minimum(w, pos + 1).astype(jnp.float32)
        diffs.append((hi - lo) / cnt[None, :, None] - full[:, POOL_HIST:, sl])
    d = jnp.stack(diffs, axis=2)
    y = jnp.einsum('btgc,gcd->btgd', d, w_pool.astype(jnp.float32)).reshape(B, T, D)
    y = (y + b_pool.astype(jnp.float32)) * scale.astype(jnp.float32)
    return y.astype(xn.dtype), full[:, -POOL_HIST:].astype(xn.dtype)


def gla_recurrence(q, k, v, log_a, s0):
    B, T = q.shape[:2]
    L = min(CHUNK, T)
    nb = T // L
    mask = jnp.tril(jnp.ones((L, L), dtype=bool))

    def to_blocks(t):
        return t.reshape(B, nb, L, *t.shape[2:]).swapaxes(0, 1)

    def step(S, xs):
        qb, kb, vb, gb = xs
        b = jnp.cumsum(gb, axis=1)
        q_dec = qb * jnp.exp(b)
        k_inv = kb * jnp.exp(-b)
        scores = jnp.where(mask, jnp.einsum('blhk,bmhk->bhlm', q_dec, k_inv), 0.0)
        o = jnp.einsum('bhlm,bmhv->blhv', scores, vb) + jnp.einsum('blhk,bhkv->blhv', q_dec, S)
        b_last = b[:, -1]
        k_end = kb * jnp.exp(b_last[:, None] - b)
        S_new = jnp.exp(b_last)[..., None] * S + jnp.einsum('blhk,blhv->bhkv', k_end, vb)
        return S_new, o

    S_fin, o = lax.scan(step, s0, (to_blocks(q), to_blocks(k), to_blocks(v), to_blocks(log_a)))
    return o.swapaxes(0, 1).reshape(B, T, GLA_HEADS, GLA_DV), S_fin


def gla_mixer(xn, s0, w_in, w_gate_up, b_gate, norm_w, w_out):
    B, T, _ = xn.shape
    proj = xn @ w_in
    q, k, v, g, gr = jnp.split(proj, [GLA_KEY_DIM, 2 * GLA_KEY_DIM, 2 * GLA_KEY_DIM + GLA_VAL_DIM,
                                      2 * GLA_KEY_DIM + 2 * GLA_VAL_DIM], axis=-1)
    log_a = jax.nn.log_sigmoid((gr @ w_gate_up + b_gate).astype(jnp.float32)) / GLA_GATE_NORMALIZER
    hk = (B, T, GLA_HEADS, GLA_DK)
    qh = q.astype(jnp.float32).reshape(hk) * (GLA_DK ** -0.5)
    kh = k.astype(jnp.float32).reshape(hk)
    vh = v.astype(jnp.float32).reshape(B, T, GLA_HEADS, GLA_DV)
    o, S = gla_recurrence(qh, kh, vh, log_a.reshape(hk), s0.astype(jnp.float32))
    o = o * lax.rsqrt(jnp.mean(o * o, axis=-1, keepdims=True) + EPS) * norm_w.astype(jnp.float32)
    o = o.reshape(B, T, GLA_VAL_DIM) * jax.nn.silu(g.astype(jnp.float32))
    return (o.astype(xn.dtype) @ w_out).astype(xn.dtype), S


def swiglu(xn, w_gate, w_up, w_down):
    return (jax.nn.silu(xn @ w_gate) * (xn @ w_up)) @ w_down


def trunk(x, p, pool_hist, gla_s0, start, norm_mix, norm_ffn, norm_ple, norm_final,
          w_pool, b_pool, pool_scale, w_gla_in, w_gla_gate_up, b_gla_gate, gla_norm, w_gla_out,
          w_ffn_gate, w_ffn_up, w_ffn_down, w_ple_proj, w_ple_gate):
    h = x
    pool_states, gla_states = [], []
    for i in range(DEPTH):
        j = i // N_MIXERS
        xn = rmsnorm(h, norm_mix[i])
        if i % N_MIXERS == 0:
            out, st = pool_mixer(xn, pool_hist[j], start, w_pool[j], b_pool[j], pool_scale[j])
            pool_states.append(st)
        else:
            out, st = gla_mixer(xn, gla_s0[j], w_gla_in[j], w_gla_gate_up[j], b_gla_gate[j],
                                gla_norm[j], w_gla_out[j])
            gla_states.append(st)
        h = h + out
        h = h + swiglu(rmsnorm(h, norm_ffn[i]), w_ffn_gate[i], w_ffn_up[i], w_ffn_down[i])
        gate = jax.nn.sigmoid(rmsnorm(h, norm_ple[i]) @ w_ple_gate[i])
        h = h + gate * (p[i].astype(h.dtype) @ w_ple_proj[i])
    return rmsnorm(h, norm_final), jnp.stack(pool_states), jnp.stack(gla_states)


def setup_inputs(seed: int = 0) -> dict:
    key = jax.random.key(seed)
    ks = jax.random.split(key, 32)
    f32 = jnp.float32

    def nrm(k, shape, scale=1.0):
        return jax.random.normal(k, shape, f32) * scale

    def gain(k, shape):
        return 1.0 + 0.05 * jax.random.normal(k, shape, f32)

    return {
        "x_prompt": nrm(ks[0], (BATCH, SEQ, D_MODEL)),
        "x_sample": nrm(ks[1], (DEC_BATCH, DEC_SEQ, D_MODEL)),
        "state_pool": nrm(ks[2], (N_POOL_LAYERS, DEC_BATCH, POOL_HIST, D_MODEL)),
        "state_gla": nrm(ks[3], (N_GLA_LAYERS, DEC_BATCH, GLA_HEADS, GLA_DK, GLA_DV), 0.5),
        "p_prompt": nrm(ks[4], (DEPTH, BATCH, SEQ, PLE_DIM)),
        "p_sample": nrm(ks[5], (DEPTH, DEC_BATCH, DEC_SEQ, PLE_DIM)),
        "norm_mix": gain(ks[6], (DEPTH, D_MODEL)),
        "norm_ffn": gain(ks[7], (DEPTH, D_MODEL)),
        "norm_ple": gain(ks[8], (DEPTH, D_MODEL)),
        "norm_final": gain(ks[9], (D_MODEL,)),
        "w_pool": nrm(ks[10], (N_POOL_LAYERS, N_POOL_GROUPS, POOL_GROUP, POOL_GROUP), POOL_GROUP ** -0.5),
        "b_pool": nrm(ks[11], (N_POOL_LAYERS, D_MODEL), 0.02),
        "pool_scale": 0.5 + 0.05 * jax.random.normal(ks[12], (N_POOL_LAYERS, D_MODEL), f32),
        "w_gla_in": nrm(ks[13], (N_GLA_LAYERS, D_MODEL, GLA_IN), D_MODEL ** -0.5),
        "w_gla_gate_up": nrm(ks[14], (N_GLA_LAYERS, GLA_GATE_RANK, GLA_KEY_DIM), GLA_GATE_RANK ** -0.5),
        "b_gla_gate": nrm(ks[15], (N_GLA_LAYERS, GLA_KEY_DIM), 0.1),
        "gla_norm": gain(ks[16], (N_GLA_LAYERS, GLA_DV)),
        "w_gla_out": nrm(ks[17], (N_GLA_LAYERS, GLA_VAL_DIM, D_MODEL), GLA_VAL_DIM ** -0.5),
        "w_ffn_gate": nrm(ks[18], (DEPTH, D_MODEL, D_FF), D_MODEL ** -0.5),
        "w_ffn_up": nrm(ks[19], (DEPTH, D_MODEL, D_FF), D_MODEL ** -0.5),
        "w_ffn_down": nrm(ks[20], (DEPTH, D_FF, D_MODEL), D_FF ** -0.5),
        "w_ple_proj": nrm(ks[21], (DEPTH, PLE_DIM, D_MODEL), PLE_DIM ** -0.5),
        "w_ple_gate": nrm(ks[22], (DEPTH, D_MODEL, D_MODEL), D_MODEL ** -0.5),
    }


def reference(x_prompt, x_sample, state_pool, state_gla, p_prompt, p_sample,
              norm_mix, norm_ffn, norm_ple, norm_final, w_pool, b_pool, pool_scale,
              w_gla_in, w_gla_gate_up, b_gla_gate, gla_norm, w_gla_out,
              w_ffn_gate, w_ffn_up, w_ffn_down, w_ple_proj, w_ple_gate):
    weights = (norm_mix, norm_ffn, norm_ple, norm_final, w_pool, b_pool, pool_scale,
               w_gla_in, w_gla_gate_up, b_gla_gate, gla_norm, w_gla_out,
               w_ffn_gate, w_ffn_up, w_ffn_down, w_ple_proj, w_ple_gate)
    b = x_prompt.shape[0]
    pool_hist0 = jnp.zeros((N_POOL_LAYERS, b, POOL_HIST, D_MODEL), x_prompt.dtype)
    gla_s00 = jnp.zeros((N_GLA_LAYERS, b, GLA_HEADS, GLA_DK, GLA_DV), jnp.float32)
    y_prompt, pool_state_prompt, gla_state_prompt = trunk(
        x_prompt, p_prompt, pool_hist0, gla_s00, 0, *weights)
    y_sample, pool_state_sample, gla_state_sample = trunk(
        x_sample, p_sample, state_pool, state_gla, PAST_LEN, *weights)
    return (y_prompt, y_sample, pool_state_prompt, pool_state_sample, gla_state_prompt, gla_state_sample)
```

```cpp
#include <hip/hip_runtime.h>
#include <hip/hip_cooperative_groups.h>
#include <cstdio>
namespace cg = cooperative_groups;

#define LAS __attribute__((address_space(3)))
typedef unsigned short bf16_t;
typedef short bf16x8 __attribute__((ext_vector_type(8)));
typedef float f32x4 __attribute__((ext_vector_type(4)));
typedef float f32x2 __attribute__((ext_vector_type(2)));
typedef unsigned u32x4 __attribute__((ext_vector_type(4)));
typedef unsigned u32x2 __attribute__((ext_vector_type(2)));

constexpr int D = 1024, MP_ROWS = 16384, MS_ROWS = 256, M = MP_ROWS + MS_ROWS, SEQ = 4096, DFF = 2816, PLE = 256;
constexpr int GIN = 3088, DK = 128, DV = 256, NH = 4, KEYD = 512;
constexpr int MPAD = M + 64;
constexpr int NITEM = 1024 + 64;
constexpr float EPS = 1e-6f;
constexpr int NT = 512;
constexpr int LDS_MAIN = 131072;
constexpr int LDS_BYTES = LDS_MAIN + 16;
#ifndef PHMASK
#define PHMASK 0xFFFF
#endif
#define EN(n) (((PHMASK) >> (n)) & 1)

constexpr size_t SZ_HB = (size_t)M * D * 2;
constexpr size_t O_WP = 0;
constexpr size_t O_WGU = O_WP + 4 * 256 * 256 * 2;
constexpr size_t O_WD = O_WGU + (size_t)2 * 5632 * 1024 * 2;
constexpr size_t O_WPG = O_WD + (size_t)2 * 1024 * 2816 * 2;
constexpr size_t O_WPP = O_WPG + (size_t)2 * 1024 * 1024 * 2;
constexpr size_t O_WIN = O_WPP + (size_t)2 * 1024 * 256 * 2;
constexpr size_t O_WGR = O_WIN + (size_t)3072 * 1024 * 2;
constexpr size_t O_WO = O_WGR + 16 * 1024 * 2;
constexpr size_t O_GR = O_WO + (size_t)1024 * 1024 * 2;
constexpr size_t O_SSQ = O_GR + (size_t)M * 16 * 4;
constexpr size_t O_DEC = O_SSQ + (size_t)7 * M * 4;
constexpr size_t O_BAR = O_DEC + (size_t)NITEM * 128 * 4;
constexpr size_t BAR_BYTES = 32768;
constexpr size_t O_HBA = O_BAR + BAR_BYTES;
constexpr size_t O_HBB = O_HBA + SZ_HB;
constexpr size_t O_BIG = O_HBB + SZ_HB;
constexpr size_t SZ_PB = (size_t)M * PLE * 2;
constexpr size_t O_PB1 = O_BIG;
constexpr size_t O_PP = O_BIG + SZ_PB;
constexpr size_t O_ACT = O_PP + SZ_HB;
constexpr size_t O_DM = O_ACT;
constexpr size_t O_PB0 = O_HBB;
constexpr size_t O_Q = O_HBB;
constexpr size_t O_K = O_HBB + (size_t)M * 512 * 2;
constexpr size_t O_OG = O_HBA;
constexpr size_t O_G = O_BIG + SZ_PB;
constexpr size_t O_VT = O_G + SZ_HB;
constexpr size_t O_KVT = O_VT + (size_t)1024 * MPAD * 2;
constexpr size_t WS_END_A = O_ACT + (size_t)M * DFF * 2;
constexpr size_t WS_END_B = O_KVT + (size_t)NITEM * 256 * 128 * 2;
constexpr size_t WS_NEED = WS_END_A > WS_END_B ? WS_END_A : WS_END_B;

constexpr size_t OUT_Y = 0;
constexpr size_t OUT_PSP = (size_t)M * D;
constexpr size_t OUT_PSS = OUT_PSP + 4 * 15 * 1024;
constexpr size_t OUT_GSP = OUT_PSS + 16 * 15 * 1024;
constexpr size_t OUT_GSS = OUT_GSP + (size_t)16 * 128 * 256;

struct Params {
    const float* in[23];
    float* out;
    unsigned char* ws;
    int ph_lo, ph_hi;
};

__device__ __forceinline__ unsigned cvt_pk_bf16(float lo, float hi) { unsigned r; asm volatile("v_cvt_pk_bf16_f32 %0, %1, %2" : "=v"(r) : "v"(lo), "v"(hi)); return r; }
__device__ __forceinline__ float bf_lo(unsigned w) { return __uint_as_float(w << 16); }
__device__ __forceinline__ float bf_hi(unsigned w) { return __uint_as_float(w & 0xffff0000u); }
__device__ __forceinline__ float bf1(bf16_t b) { return __uint_as_float(((unsigned)b) << 16); }
__device__ __forceinline__ float sigmoidf_(float x) { return __builtin_amdgcn_rcpf(1.0f + __expf(-x)); }
__device__ __forceinline__ float siluf_(float x) { return x * sigmoidf_(x); }
__device__ __forceinline__ float rinv_of(float ssq) { return rsqrtf(ssq * (1.0f / 1024.0f) + EPS); }


#define XB_TMO      128
#define XB_XCNT(j)  (256  + 64 * (j))
#define XB_XSUB(j)  (1280 + 64 * (j))
#define XB_XGEN(j)  (2304 + 64 * (j))
#define XB_TOP      3328
#define XB_TOPGEN   3392
#define XB_SPIN_CAP (1u << 18)
__device__ __forceinline__ unsigned xb_ld(unsigned* p)              { return __hip_atomic_load(p, __ATOMIC_RELAXED, __HIP_MEMORY_SCOPE_AGENT); }
__device__ __forceinline__ unsigned xb_add(unsigned* p, unsigned v) { return __hip_atomic_fetch_add(p, v, __ATOMIC_RELAXED, __HIP_MEMORY_SCOPE_AGENT); }
__device__ __forceinline__ unsigned xb_xcc_id() { return (unsigned)__builtin_amdgcn_s_getreg((3 << 11) | 20) & 0xFu; }
#define XB_SPIN(cond, bar) do { unsigned _sp = 0; while (cond) { __builtin_amdgcn_s_sleep(1); \
    if ((++_sp & 255u) == 0u) { if (xb_ld(&(bar)[XB_TMO])) break; if (_sp > XB_SPIN_CAP) { atomicAdd(&(bar)[XB_TMO], 1u); break; } } } } while (0)
struct XcdBarrier { unsigned* bar; unsigned x; volatile LAS unsigned* st; };
__device__ __forceinline__ XcdBarrier xcd_barrier_post(unsigned* bar, volatile LAS unsigned* st) {
    XcdBarrier b; b.bar = bar; b.x = xb_xcc_id(); b.st = st;
    if (threadIdx.x == 0) (void)xb_add(&bar[XB_XCNT(b.x)], 1u);
    return b;
}
__device__ __forceinline__ void xcd_barrier_complete(unsigned* bar, unsigned x, unsigned& nloc, unsigned& nx) {
    const unsigned G = gridDim.x * gridDim.y * gridDim.z;
    unsigned sum, cnt, mine, sp = 0u;
    for (;;) {
        sum = 0u; cnt = 0u; mine = 0u;
#pragma unroll
        for (unsigned j = 0; j < 16; ++j) { const unsigned c = xb_ld(&bar[XB_XCNT(j)]); sum += c; cnt += (c > 0u) ? 1u : 0u; mine = (j == x) ? c : mine; }
        if (sum == G) break;
        __builtin_amdgcn_s_sleep(1);
        if ((++sp & 255u) == 0u) { if (xb_ld(&bar[XB_TMO])) break; if (sp > XB_SPIN_CAP) { atomicAdd(&bar[XB_TMO], 1u); break; } }
    }
    nloc = mine > 0u ? mine : 1u; nx = cnt > 0u ? cnt : 1u;
}
__device__ __forceinline__ void xcd_barrier(const XcdBarrier& b) {
    asm volatile("s_waitcnt vmcnt(0)" ::: "memory");
    __syncthreads();
    if (threadIdx.x == 0) {
        unsigned* bar = b.bar;
        __builtin_amdgcn_s_waitcnt(0);
        unsigned nloc = b.st[0], nx = b.st[1];
        if (nloc == 0u) { xcd_barrier_complete(bar, b.x, nloc, nx); b.st[0] = nloc; b.st[1] = nx; }
        const unsigned old = xb_add(&bar[XB_XSUB(b.x)], 1u);
        const unsigned gen = old / nloc;
        if (old + 1u == (gen + 1u) * nloc) {
            __builtin_amdgcn_fence(__ATOMIC_RELEASE, "agent");
            asm volatile("s_waitcnt vmcnt(0)" ::: "memory");
            const unsigned og = xb_add(&bar[XB_TOP], 1u);
            const unsigned tg = og / nx;
            if (og + 1u == (tg + 1u) * nx) xb_add(&bar[XB_TOPGEN], 1u);
            else XB_SPIN(xb_ld(&bar[XB_TOPGEN]) == tg, bar);
            __builtin_amdgcn_fence(__ATOMIC_ACQUIRE, "agent");
            xb_add(&bar[XB_XGEN(b.x)], 1u);
            asm volatile("s_waitcnt vmcnt(0)" ::: "memory");
        } else {
            XB_SPIN(xb_ld(&bar[XB_XGEN(b.x)]) == gen, bar);
            __builtin_amdgcn_fence(__ATOMIC_ACQUIRE, "agent");
            asm volatile("s_waitcnt vmcnt(0)" ::: "memory");
        }
    }
    __syncthreads();
}

namespace pg8 {
constexpr int BM = 256, BK = 64, HALF = 128, HTB = HALF * BK * 2, NXCD = 8, WGM = 4;
__device__ __forceinline__ int lds_byte(int r, int c) { const int st = (r >> 4) * 2 + (c >> 5), rr = r & 15, cc = c & 31, ob = rr * 64 + cc * 2; return st * 1024 + (ob ^ (((ob >> 9) & 1) << 5)); }
__device__ __forceinline__ void stage_rc(int b, int& R, int& C) { const int st = b / 1024, sb = b % 1024, swz = sb ^ (((sb >> 9) & 1) << 5); R = (st >> 1) * 16 + swz / 64; C = (st & 1) * 32 + (swz % 64) / 2; }
__device__ __forceinline__ int perm32(int rho) { const int n = rho >> 4, i = rho & 15; return 8 * (i >> 2) + 4 * n + (i & 3); }
struct Unit { int pm, pn; };
struct Gemm { const bf16_t* A; const bf16_t* Bt; int lda, ldb, K, a_pn_off; };
struct StaticOrder {
    int nM, nN, nwg, G, c;
    __device__ __forceinline__ void init(int nM_, int nN_, int G_, int c_) { nM = nM_; nN = nN_; nwg = nM * nN; G = G_; c = c_; }
    __device__ __forceinline__ bool next(int i, Unit& u) const {
        const long L = (long)i * G + c; if (L >= nwg) return false;
        int wgid = (int)L; { const int q = nwg / NXCD, r = nwg % NXCD, xcd = wgid % NXCD, off = wgid / NXCD; wgid = (xcd < r ? xcd * (q + 1) : r * (q + 1) + (xcd - r) * q) + off; }
        const int nig = WGM * nN, gid = wgid / nig, fm = gid * WGM, gsz = (nM - fm) < WGM ? (nM - fm) : WGM;
        u.pm = fm + ((wgid % nig) % gsz); u.pn = (wgid % nig) / gsz; return true;
    }
};

template <class Epi>
__device__ __forceinline__ void gemm_phase(LAS unsigned char* lds, const Gemm g, const StaticOrder& S, const Epi& E) {
    int tid = threadIdx.x; asm volatile("" : "+v"(tid));
    const int wid = __builtin_amdgcn_readfirstlane(tid >> 6), lane = tid & 63, wr = wid >> 2, wc = wid & 3, fr = lane & 15, fq = lane >> 4;
    int K = g.K; asm volatile("" : "+s"(K));
    const int nt = K / BK;
    unsigned voffA[2], voffB[2];
#pragma unroll
    for (int i = 0; i < 2; ++i) { int R, C; stage_rc(tid * 16 + i * 8192, R, C); const int Rb = (R & ~31) + perm32(R & 31);
        voffA[i] = (unsigned)(R * g.lda + C) * 2u; voffB[i] = (unsigned)(Rb * g.ldb + C) * 2u; }
    const size_t kstep = (size_t)(BK * 2);
    const size_t hstepA = (size_t)HALF * g.lda * 2, hstepB = (size_t)HALF * g.ldb * 2;
    const size_t tstepA = 2 * hstepA, tstepB = 2 * hstepB;
    const unsigned ldsw = (unsigned)wid * 1024u;
    const int aoff = lds_byte(wr * 64 + fr, fq * 8), boff = lds_byte(wc * 32 + fr, fq * 8);
#define PG8_SA(b, h) (((b) * 2 + (h)) * HTB)
#define PG8_SB(b, h) ((4 + (b) * 2 + (h)) * HTB)
#define PG8_STAGE(bufoff, gbase, voff) do { _Pragma("unroll") for (int _i = 0; _i < 2; ++_i) \
        __builtin_amdgcn_global_load_lds((const unsigned*)((const char*)(gbase) + (voff)[_i]), (LAS unsigned*)(lds + (bufoff) + ldsw + _i * 8192), 16, 0, 0); } while (0)
#define PG8_LDA(dst, b, h) do { _Pragma("unroll") for (int m = 0; m < 4; ++m) _Pragma("unroll") for (int k = 0; k < 2; ++k) dst[m][k] = *(const LAS bf16x8*)(lds + PG8_SA(b, h) + aoff + m * 2048 + k * 1024); } while (0)
#define PG8_LDB(dst, b, h) do { _Pragma("unroll") for (int n = 0; n < 2; ++n) _Pragma("unroll") for (int k = 0; k < 2; ++k) dst[n][k] = *(const LAS bf16x8*)(lds + PG8_SB(b, h) + boff + n * 2048 + k * 1024); } while (0)
#define PG8_MMA(ai, bj, At, Bt) do { __builtin_amdgcn_s_setprio(1); _Pragma("unroll") for (int m = 0; m < 4; ++m) _Pragma("unroll") for (int n = 0; n < 2; ++n) _Pragma("unroll") for (int k = 0; k < 2; ++k) \
        acc[ai][bj][m][n] = __builtin_amdgcn_mfma_f32_16x16x32_bf16(Bt[n][k], At[m][k], acc[ai][bj][m][n], 0, 0, 0); __builtin_amdgcn_s_setprio(0); } while (0)
#define PG8_WAIT_V(n) asm volatile("s_waitcnt vmcnt(" #n ")" ::: "memory")
#define PG8_WAIT_L(n) asm volatile("s_waitcnt lgkmcnt(" #n ")" ::: "memory")
#define PG8_BAR __builtin_amdgcn_s_barrier()
#define PG8_SCHED __builtin_amdgcn_sched_barrier(0)
    Unit cur, nxt; int ui = 0;
    if (!S.next(0, cur)) return;
    f32x4 acc[2][2][4][2];
#pragma unroll
    for (int a = 0; a < 2; ++a)
#pragma unroll
        for (int b = 0; b < 2; ++b)
#pragma unroll
            for (int m = 0; m < 4; ++m)
#pragma unroll
                for (int n = 0; n < 2; ++n) acc[a][b][m][n] = (f32x4){0.f, 0.f, 0.f, 0.f};
    bf16x8 At[4][2], B0[2][2], B1[2][2];
    const char* cA = (const char*)g.A + (size_t)cur.pm * tstepA + (size_t)cur.pn * g.a_pn_off * 2; const char* cB = (const char*)g.Bt + (size_t)cur.pn * tstepB;
    PG8_STAGE(PG8_SB(0, 0), cB, voffB); PG8_STAGE(PG8_SA(0, 0), cA, voffA); PG8_STAGE(PG8_SB(0, 1), cB + hstepB, voffB); PG8_STAGE(PG8_SA(0, 1), cA + hstepA, voffA);
    if (wr == 1) PG8_BAR;
    PG8_WAIT_V(4); PG8_BAR;
    PG8_STAGE(PG8_SB(1, 0), cB + kstep, voffB); PG8_STAGE(PG8_SA(1, 0), cA + kstep, voffA); PG8_STAGE(PG8_SB(1, 1), cB + hstepB + kstep, voffB);
    PG8_WAIT_V(6); PG8_BAR;
    for (;;) {
        const bool has_next = S.next(ui + 1, nxt);
        const char* nA = has_next ? (const char*)g.A + (size_t)nxt.pm * tstepA + (size_t)nxt.pn * g.a_pn_off * 2 : cA; const char* nB = has_next ? (const char*)g.Bt + (size_t)nxt.pn * tstepB : cB;
        for (int t = 0; t < nt; t += 2) {
            const bool last = (t == nt - 2);
            const char* a1 = cA + (size_t)(t + 1) * kstep;
            const char* a2 = last ? nA : cA + (size_t)(t + 2) * kstep; const char* b2 = last ? nB : cB + (size_t)(t + 2) * kstep;
            const char* a3 = a2 + kstep; const char* b3 = b2 + kstep;
            PG8_LDB(B0, 0, 0); PG8_SCHED; PG8_LDA(At, 0, 0); PG8_STAGE(PG8_SA(1, 1), a1 + hstepA, voffA);
            PG8_WAIT_L(8); PG8_BAR; PG8_WAIT_L(0); PG8_MMA(0, 0, At, B0); PG8_BAR; PG8_SCHED;
            PG8_LDB(B1, 0, 1); PG8_STAGE(PG8_SB(0, 0), b2, voffB);
            PG8_BAR; PG8_WAIT_L(0); PG8_MMA(0, 1, At, B1); PG8_BAR;
            PG8_LDA(At, 0, 1); PG8_STAGE(PG8_SA(0, 0), a2, voffA);
            PG8_BAR; PG8_WAIT_L(0); PG8_MMA(1, 0, At, B0); PG8_BAR; PG8_SCHED;
            PG8_STAGE(PG8_SB(0, 1), b2 + hstepB, voffB);
            PG8_WAIT_V(6); PG8_BAR; PG8_MMA(1, 1, At, B1); PG8_BAR;
            PG8_LDB(B0, 1, 0); PG8_SCHED; PG8_LDA(At, 1, 0); PG8_STAGE(PG8_SA(0, 1), a2 + hstepA, voffA);
            PG8_WAIT_L(8); PG8_BAR; PG8_WAIT_L(0); PG8_MMA(0, 0, At, B0); PG8_BAR; PG8_SCHED;
            PG8_LDB(B1, 1, 1); PG8_STAGE(PG8_SB(1, 0), b3, voffB);
            PG8_BAR; PG8_WAIT_L(0); PG8_MMA(0, 1, At, B1); PG8_BAR;
            PG8_LDA(At, 1, 1); PG8_STAGE(PG8_SA(1, 0), a3, voffA);
            PG8_BAR; PG8_WAIT_L(0); PG8_MMA(1, 0, At, B0); PG8_BAR; PG8_SCHED;
            PG8_STAGE(PG8_SB(1, 1), b3 + hstepB, voffB);
            PG8_WAIT_V(6); PG8_BAR; PG8_MMA(1, 1, At, B1); PG8_BAR;
        }
        E(acc, cur, wr, wc, fr, fq);
        if (!has_next) break;
#pragma unroll
        for (int a = 0; a < 2; ++a)
#pragma unroll
            for (int b = 0; b < 2; ++b)
#pragma unroll
                for (int m = 0; m < 4; ++m)
#pragma unroll
                    for (int n = 0; n < 2; ++n) acc[a][b][m][n] = (f32x4){0.f, 0.f, 0.f, 0.f};
        cur = nxt; cA = nA; cB = nB; ++ui;
    }
    PG8_WAIT_V(0);
    if (wr == 0) PG8_BAR;
    PG8_BAR;
#undef PG8_SA
#undef PG8_SB
#undef PG8_STAGE
#undef PG8_LDA
#undef PG8_LDB
#undef PG8_MMA
#undef PG8_WAIT_V
#undef PG8_WAIT_L
#undef PG8_BAR
#undef PG8_SCHED
}
}

typedef f32x4 AccT[2][2][4][2];
#define EPI_ROW(u, ai, m) ((u).pm * 256 + (ai) * 128 + wr * 64 + (m) * 16 + fr)
#define EPI_COL(u, bj) ((u).pn * 256 + (bj) * 128 + wc * 32 + 8 * fq)

__device__ __forceinline__ u32x4 pack8(const f32x4 a, const f32x4 b) { u32x4 w; w.x = cvt_pk_bf16(a[0], a[1]); w.y = cvt_pk_bf16(a[2], a[3]); w.z = cvt_pk_bf16(b[0], b[1]); w.w = cvt_pk_bf16(b[2], b[3]); return w; }
__device__ __forceinline__ float sq8(const f32x4 a, const f32x4 b) { return (a[0] * a[0] + a[1] * a[1]) + (a[2] * a[2] + a[3] * a[3]) + (b[0] * b[0] + b[1] * b[1]) + (b[2] * b[2] + b[3] * b[3]); }
__device__ __forceinline__ void ssq_commit(float s, float* ssq, int r, int fq) { s += __shfl_xor(s, 16); s += __shfl_xor(s, 32); if (fq == 0) atomicAdd(ssq + r, s); }

struct EpiPool {
    const float* xp; const float* xs; float* h; bf16_t* hb; const float* bias; const float* scale; float* ssq;
    static constexpr bool HAS_SSQ = true;
    __device__ __forceinline__ float apply8(int r, int c, const f32x4 a0, const f32x4 a1) const {
        const float* xrow = r < MP_ROWS ? xp + (size_t)r * D : xs + (size_t)(r - MP_ROWS) * D;
        const f32x4 v0 = *(const f32x4*)(xrow + c) + (a0 + *(const f32x4*)(bias + c)) * *(const f32x4*)(scale + c);
        const f32x4 v1 = *(const f32x4*)(xrow + c + 4) + (a1 + *(const f32x4*)(bias + c + 4)) * *(const f32x4*)(scale + c + 4);
        *(f32x4*)(h + (size_t)r * D + c) = v0; *(f32x4*)(h + (size_t)r * D + c + 4) = v1; *(u32x4*)(hb + (size_t)r * D + c) = pack8(v0, v1); return sq8(v0, v1); }
    __device__ __forceinline__ void operator()(const AccT& acc, const pg8::Unit& u, int wr, int wc, int fr, int fq) const {
        asm volatile("" : "+v"(fr), "+v"(fq), "+s"(wr), "+s"(wc));
#pragma unroll
        for (int ai = 0; ai < 2; ++ai)
#pragma unroll
            for (int mp = 0; mp < 2; ++mp) {
                f32x4 xv[2][2][2], bb[2][2], sc[2][2];
#pragma unroll
                for (int bj = 0; bj < 2; ++bj) { const int c = EPI_COL(u, bj); bb[bj][0] = *(const f32x4*)(bias + c); bb[bj][1] = *(const f32x4*)(bias + c + 4); sc[bj][0] = *(const f32x4*)(scale + c); sc[bj][1] = *(const f32x4*)(scale + c + 4); }
#pragma unroll
                for (int mm = 0; mm < 2; ++mm) { const int r = EPI_ROW(u, ai, 2 * mp + mm); const float* xrow = r < MP_ROWS ? xp + (size_t)r * D : xs + (size_t)(r - MP_ROWS) * D;
#pragma unroll
                    for (int bj = 0; bj < 2; ++bj) { const int c = EPI_COL(u, bj); xv[mm][bj][0] = *(const f32x4*)(xrow + c); xv[mm][bj][1] = *(const f32x4*)(xrow + c + 4); } }
#pragma unroll
                for (int mm = 0; mm < 2; ++mm) { const int m = 2 * mp + mm, r = EPI_ROW(u, ai, m); float s = 0.f;
#pragma unroll
                    for (int bj = 0; bj < 2; ++bj) { const int c = EPI_COL(u, bj);
                        const f32x4 v0 = xv[mm][bj][0] + (acc[ai][bj][m][0] + bb[bj][0]) * sc[bj][0], v1 = xv[mm][bj][1] + (acc[ai][bj][m][1] + bb[bj][1]) * sc[bj][1];
                        *(f32x4*)(h + (size_t)r * D + c) = v0; *(f32x4*)(h + (size_t)r * D + c + 4) = v1;
                        *(u32x4*)(hb + (size_t)r * D + c) = pack8(v0, v1); s += sq8(v0, v1); }
                    ssq_commit(s, ssq, r, fq); }
                asm volatile("" ::: "memory"); }
    }
};
struct EpiRes {
    float* h; bf16_t* hb; float* ssq; float mul;
    static constexpr bool HAS_SSQ = true;
    __device__ __forceinline__ float apply8(int r, int c, const f32x4 a0, const f32x4 a1) const {
        float* hp = h + (size_t)r * D + c; const f32x4 v0 = *(const f32x4*)hp + a0 * mul, v1 = *(const f32x4*)(hp + 4) + a1 * mul;
        *(f32x4*)hp = v0; *(f32x4*)(hp + 4) = v1; *(u32x4*)(hb + (size_t)r * D + c) = pack8(v0, v1); return sq8(v0, v1); }
    __device__ __forceinline__ void operator()(const AccT& acc, const pg8::Unit& u, int wr, int wc, int fr, int fq) const {
        asm volatile("" : "+v"(fr), "+v"(fq), "+s"(wr), "+s"(wc));
#pragma unroll
        for (int ai = 0; ai < 2; ++ai) {
            f32x4 hv[4][2][2];
#pragma unroll
            for (int m = 0; m < 4; ++m)
#pragma unroll
                for (int bj = 0; bj < 2; ++bj) { const float* hp = h + (size_t)EPI_ROW(u, ai, m) * D + EPI_COL(u, bj); hv[m][bj][0] = *(const f32x4*)hp; hv[m][bj][1] = *(const f32x4*)(hp + 4); }
#pragma unroll
            for (int m = 0; m < 4; ++m) {
                const int r = EPI_ROW(u, ai, m); float s = 0.f;
#pragma unroll
                for (int bj = 0; bj < 2; ++bj) { const int c = EPI_COL(u, bj); float* hp = h + (size_t)r * D + c;
                    const f32x4 v0 = hv[m][bj][0] + acc[ai][bj][m][0] * mul, v1 = hv[m][bj][1] + acc[ai][bj][m][1] * mul;
                    *(f32x4*)hp = v0; *(f32x4*)(hp + 4) = v1;
                    *(u32x4*)(hb + (size_t)r * D + c) = pack8(v0, v1); s += sq8(v0, v1); }
                ssq_commit(s, ssq, r, fq); }
            asm volatile("" ::: "memory"); }
    }
};
struct EpiPle {
    float* h; bf16_t* hb; const bf16_t* pp; const float* ssq_in; float* ssq; float mul;
    static constexpr bool HAS_SSQ = true;
    __device__ __forceinline__ float apply8(int r, int c, const f32x4 a0_, const f32x4 a1_) const {
        const float ri = rinv_of(ssq_in[r]); float* hp = h + (size_t)r * D + c; const u32x4 pw = *(const u32x4*)(pp + (size_t)r * D + c);
        const f32x4 a0 = a0_ * ri, a1 = a1_ * ri; f32x4 v0 = *(const f32x4*)hp, v1 = *(const f32x4*)(hp + 4);
        if (mul == 0.f) { *(u32x4*)(hb + (size_t)r * D + c) = pack8(v0, v1); return 0.f; }
        v0[0] += sigmoidf_(a0[0]) * bf_lo(pw.x); v0[1] += sigmoidf_(a0[1]) * bf_hi(pw.x); v0[2] += sigmoidf_(a0[2]) * bf_lo(pw.y); v0[3] += sigmoidf_(a0[3]) * bf_hi(pw.y);
        v1[0] += sigmoidf_(a1[0]) * bf_lo(pw.z); v1[1] += sigmoidf_(a1[1]) * bf_hi(pw.z); v1[2] += sigmoidf_(a1[2]) * bf_lo(pw.w); v1[3] += sigmoidf_(a1[3]) * bf_hi(pw.w);
        *(f32x4*)hp = v0; *(f32x4*)(hp + 4) = v1; *(u32x4*)(hb + (size_t)r * D + c) = pack8(v0, v1); return sq8(v0, v1); }
    __device__ __forceinline__ void operator()(const AccT& acc, const pg8::Unit& u, int wr, int wc, int fr, int fq) const {
        asm volatile("" : "+v"(fr), "+v"(fq), "+s"(wr), "+s"(wc));
#pragma unroll
        for (int ai = 0; ai < 2; ++ai)
#pragma unroll
            for (int mp = 0; mp < 2; ++mp) {
                f32x4 hv[2][2][2]; u32x4 pw[2][2]; float rs[2];
#pragma unroll
                for (int mm = 0; mm < 2; ++mm) { const int r = EPI_ROW(u, ai, 2 * mp + mm); rs[mm] = ssq_in[r];
#pragma unroll
                    for (int bj = 0; bj < 2; ++bj) { const int c = EPI_COL(u, bj); const float* hp = h + (size_t)r * D + c; hv[mm][bj][0] = *(const f32x4*)hp; hv[mm][bj][1] = *(const f32x4*)(hp + 4); pw[mm][bj] = *(const u32x4*)(pp + (size_t)r * D + c); } }
#pragma unroll
                for (int mm = 0; mm < 2; ++mm) { const int m = 2 * mp + mm, r = EPI_ROW(u, ai, m); float s = 0.f; const float ri = rinv_of(rs[mm]);
#pragma unroll
                    for (int bj = 0; bj < 2; ++bj) { const int c = EPI_COL(u, bj); float* hp = h + (size_t)r * D + c; const u32x4 p4 = pw[mm][bj];
                        const f32x4 a0 = acc[ai][bj][m][0] * ri, a1 = acc[ai][bj][m][1] * ri; f32x4 v0 = hv[mm][bj][0], v1 = hv[mm][bj][1];
                        v0[0] += mul * sigmoidf_(a0[0]) * bf_lo(p4.x); v0[1] += mul * sigmoidf_(a0[1]) * bf_hi(p4.x); v0[2] += mul * sigmoidf_(a0[2]) * bf_lo(p4.y); v0[3] += mul * sigmoidf_(a0[3]) * bf_hi(p4.y);
                        v1[0] += mul * sigmoidf_(a1[0]) * bf_lo(p4.z); v1[1] += mul * sigmoidf_(a1[1]) * bf_hi(p4.z); v1[2] += mul * sigmoidf_(a1[2]) * bf_lo(p4.w); v1[3] += mul * sigmoidf_(a1[3]) * bf_hi(p4.w);
                        *(f32x4*)hp = v0; *(f32x4*)(hp + 4) = v1;
                        *(u32x4*)(hb + (size_t)r * D + c) = pack8(v0, v1); s += sq8(v0, v1); }
                    ssq_commit(s, ssq, r, fq); }
                asm volatile("" ::: "memory"); }
    }
};
struct EpiGU {
    bf16_t* act; const float* ssq_in;
    __device__ __forceinline__ void operator()(const AccT& acc, const pg8::Unit& u, int wr, int wc, int fr, int fq) const {
        asm volatile("" : "+v"(fr), "+v"(fq), "+s"(wr), "+s"(wc));
        float ris[2][4];
#pragma unroll
        for (int ai = 0; ai < 2; ++ai)
#pragma unroll
            for (int m = 0; m < 4; ++m) ris[ai][m] = ssq_in[EPI_ROW(u, ai, m)];
#pragma unroll
        for (int ai = 0; ai < 2; ++ai)
#pragma unroll
            for (int m = 0; m < 4; ++m) {
                const int r = EPI_ROW(u, ai, m); const float ri = rinv_of(ris[ai][m]);
                f32x4 o[2];
#pragma unroll
                for (int n = 0; n < 2; ++n) { const f32x4 gt = acc[ai][0][m][n] * ri, up = acc[ai][1][m][n] * ri;
#pragma unroll
                    for (int j = 0; j < 4; ++j) o[n][j] = siluf_(gt[j]) * up[j]; }
                *(u32x4*)(act + (size_t)r * DFF + u.pn * 128 + wc * 32 + 8 * fq) = pack8(o[0], o[1]); }
    }
};
struct EpiBf {
    bf16_t* O; int ldc;
    static constexpr bool HAS_SSQ = false; float* ssq;
    __device__ __forceinline__ float apply8(int r, int c, const f32x4 a0, const f32x4 a1) const { *(u32x4*)(O + (size_t)r * ldc + c) = pack8(a0, a1); return 0.f; }
    __device__ __forceinline__ void operator()(const AccT& acc, const pg8::Unit& u, int wr, int wc, int fr, int fq) const {
        asm volatile("" : "+v"(fr), "+v"(fq), "+s"(wr), "+s"(wc));
#pragma unroll
        for (int ai = 0; ai < 2; ++ai)
#pragma unroll
            for (int m = 0; m < 4; ++m) { const int r = EPI_ROW(u, ai, m);
#pragma unroll
                for (int bj = 0; bj < 2; ++bj) { const int c = EPI_COL(u, bj); *(u32x4*)(O + (size_t)r * ldc + c) = pack8(acc[ai][bj][m][0], acc[ai][bj][m][1]); } }
    }
};
struct EpiQKG {
    bf16_t* q; bf16_t* k; bf16_t* g; const float* ssq_in;
    static constexpr bool HAS_SSQ = false; float* ssq;
    __device__ __forceinline__ float apply8(int r, int c, const f32x4 a0, const f32x4 a1) const {
        bf16_t* base; int ldc, cc; float sc = 1.0f;
        if (c < 512) { base = q; ldc = KEYD; cc = c; sc = 0.08838834764831845f; } else if (c < 1024) { base = k; ldc = KEYD; cc = c - 512; } else { base = g; ldc = D; cc = c - 1024; }
        const float ri = rinv_of(ssq_in[r]) * sc; *(u32x4*)(base + (size_t)r * ldc + cc) = pack8(a0 * ri, a1 * ri); return 0.f; }
    __device__ __forceinline__ void operator()(const AccT& acc, const pg8::Unit& u, int wr, int wc, int fr, int fq) const {
        asm volatile("" : "+v"(fr), "+v"(fq), "+s"(wr), "+s"(wc));
        bf16_t* base; int ldc, ct; float sc = 1.0f;
        if (u.pn < 2) { base = q; ldc = KEYD; ct = u.pn; sc = 0.08838834764831845f; } else if (u.pn < 4) { base = k; ldc = KEYD; ct = u.pn - 2; } else { base = g; ldc = D; ct = u.pn - 4; }
        float ris[2][4];
#pragma unroll
        for (int ai = 0; ai < 2; ++ai)
#pragma unroll
            for (int m = 0; m < 4; ++m) ris[ai][m] = ssq_in[EPI_ROW(u, ai, m)];
#pragma unroll
        for (int ai = 0; ai < 2; ++ai)
#pragma unroll
            for (int m = 0; m < 4; ++m) { const int r = EPI_ROW(u, ai, m); const float ri = rinv_of(ris[ai][m]) * sc;
#pragma unroll
                for (int bj = 0; bj < 2; ++bj) { const int c = ct * 256 + bj * 128 + wc * 32 + 8 * fq;
                    *(u32x4*)(base + (size_t)r * ldc + c) = pack8(acc[ai][bj][m][0] * ri, acc[ai][bj][m][1] * ri); } }
    }
};
struct EpiVT {
    bf16_t* vT; const float* ssq_in;
    static constexpr bool HAS_SSQ = false; float* ssq;
    __device__ __forceinline__ float apply8(int r, int c, const f32x4 a0, const f32x4 a1) const {
        const float ri = rinv_of(ssq_in[r]); const u32x4 w = pack8(a0 * ri, a1 * ri); bf16_t* p = vT + (size_t)c * MPAD + r;
        p[0] = (bf16_t)(w.x & 0xffffu); p[MPAD] = (bf16_t)(w.x >> 16); p[2 * (size_t)MPAD] = (bf16_t)(w.y & 0xffffu); p[3 * (size_t)MPAD] = (bf16_t)(w.y >> 16);
        p[4 * (size_t)MPAD] = (bf16_t)(w.z & 0xffffu); p[5 * (size_t)MPAD] = (bf16_t)(w.z >> 16); p[6 * (size_t)MPAD] = (bf16_t)(w.w & 0xffffu); p[7 * (size_t)MPAD] = (bf16_t)(w.w >> 16); return 0.f; }
    __device__ __forceinline__ void operator()(const AccT& acc, const pg8::Unit& u, int wr, int wc, int fr, int fq) const {
        asm volatile("" : "+v"(fr), "+v"(fq), "+s"(wr), "+s"(wc));
        f32x4 rs[2][2];
#pragma unroll
        for (int bj = 0; bj < 2; ++bj) { const int c = EPI_COL(u, bj); const f32x4 s0 = *(const f32x4*)(ssq_in + c), s1 = *(const f32x4*)(ssq_in + c + 4);
#pragma unroll
            for (int j = 0; j < 4; ++j) { rs[bj][0][j] = rinv_of(s0[j]); rs[bj][1][j] = rinv_of(s1[j]); } }
#pragma unroll
        for (int ai = 0; ai < 2; ++ai)
#pragma unroll
            for (int m = 0; m < 4; ++m) { const int r = EPI_ROW(u, ai, m);
#pragma unroll
                for (int bj = 0; bj < 2; ++bj) { const int c = EPI_COL(u, bj);
                    *(u32x4*)(vT + (size_t)r * MPAD + c) = pack8(acc[ai][bj][m][0] * rs[bj][0], acc[ai][bj][m][1] * rs[bj][1]); } }
    }
};


template <class Epi>
__device__ __forceinline__ void small_gemm(unsigned char* lds, const bf16_t* A, int lda, const bf16_t* Bt, int ldb, int K, int ncol_tiles, int a_grp_off, const Epi& E, int first = -1, int stride = 0) {
    int tid = threadIdx.x; asm volatile("" : "+v"(tid));
    const int wid = tid >> 6, lane = tid & 63, fr = lane & 15, fq = lane >> 4;
    float* part = (float*)lds;
    const int kw = K >> 3, ksteps = kw >> 5;
    if (first < 0) { first = blockIdx.x; stride = gridDim.x; }
    for (int tile = first; tile < 8 * ncol_tiles; tile += stride) {
        const int rt = tile & 7, ct = tile >> 3, r0 = MP_ROWS + 32 * rt, c0 = 32 * ct;
        const bf16_t* ap = A + (size_t)(r0 + fr) * lda + (c0 >> 8) * a_grp_off + wid * kw + 8 * fq;
        const bf16_t* bp = Bt + (size_t)(c0 + fr) * ldb + wid * kw + 8 * fq;
        f32x4 acc[2][2];
#pragma unroll
        for (int i = 0; i < 2; ++i)
#pragma unroll
            for (int j = 0; j < 2; ++j) acc[i][j] = (f32x4){0.f, 0.f, 0.f, 0.f};
        for (int s0 = 0; s0 < ksteps; s0 += 4) {
            bf16x8 a0[4], a1[4], b0[4], b1[4];
#pragma unroll
            for (int j = 0; j < 4; ++j) if (s0 + j < ksteps) { const int s = s0 + j;
                a0[j] = *(const bf16x8*)(ap + 32 * s); a1[j] = *(const bf16x8*)(ap + (size_t)16 * lda + 32 * s);
                b0[j] = *(const bf16x8*)(bp + 32 * s); b1[j] = *(const bf16x8*)(bp + (size_t)16 * ldb + 32 * s); }
#pragma unroll
            for (int j = 0; j < 4; ++j) if (s0 + j < ksteps) {
                acc[0][0] = __builtin_amdgcn_mfma_f32_16x16x32_bf16(b0[j], a0[j], acc[0][0], 0, 0, 0); acc[0][1] = __builtin_amdgcn_mfma_f32_16x16x32_bf16(b1[j], a0[j], acc[0][1], 0, 0, 0);
                acc[1][0] = __builtin_amdgcn_mfma_f32_16x16x32_bf16(b0[j], a1[j], acc[1][0], 0, 0, 0); acc[1][1] = __builtin_amdgcn_mfma_f32_16x16x32_bf16(b1[j], a1[j], acc[1][1], 0, 0, 0); } }
#pragma unroll
        for (int i = 0; i < 2; ++i)
#pragma unroll
            for (int j = 0; j < 2; ++j) *(f32x4*)(part + (wid * 32 + 16 * i + fr) * 36 + 16 * j + 4 * fq) = acc[i][j];
        __syncthreads();
        if (tid < 128) { const int row = tid >> 2, oct = tid & 3; f32x4 v0 = (f32x4){0.f, 0.f, 0.f, 0.f}, v1 = v0;
#pragma unroll
            for (int w = 0; w < 8; ++w) { v0 += *(const f32x4*)(part + (w * 32 + row) * 36 + 8 * oct); v1 += *(const f32x4*)(part + (w * 32 + row) * 36 + 8 * oct + 4); }
            float sq = E.apply8(r0 + row, c0 + 8 * oct, v0, v1);
            if (Epi::HAS_SSQ) { sq += __shfl_xor(sq, 1); sq += __shfl_xor(sq, 2); if (oct == 0) atomicAdd(E.ssq + r0 + row, sq); } }
        __syncthreads();
    }
}

__device__ __forceinline__ void transpose_tile(const float* src, int ldsrc, int k0, int n0, bf16_t* dst, int ldd, const float* gain, int rowmode, float* T) {
    const int tid = threadIdx.x;
    { const int kk = tid >> 4, n4 = (tid & 15) * 4; const float* gp = gain ? gain : src;
        const f32x4 v0 = *(const f32x4*)(src + (size_t)(k0 + kk) * ldsrc + n0 + n4), v1 = *(const f32x4*)(src + (size_t)(k0 + kk + 32) * ldsrc + n0 + n4);
        float g0 = gp[k0 + kk], g1 = gp[k0 + kk + 32]; if (!gain) { g0 = 1.0f; g1 = 1.0f; }
#pragma unroll
        for (int j = 0; j < 4; ++j) { T[(n4 + j) * 65 + kk] = v0[j] * g0; T[(n4 + j) * 65 + kk + 32] = v1[j] * g1; } }
    __syncthreads();
    { const int n = tid >> 3, k8 = (tid & 7) * 8; const float* tp = T + n * 65 + k8; u32x4 w;
        w.x = cvt_pk_bf16(tp[0], tp[1]); w.y = cvt_pk_bf16(tp[2], tp[3]); w.z = cvt_pk_bf16(tp[4], tp[5]); w.w = cvt_pk_bf16(tp[6], tp[7]);
        const int nn = n0 + n; int row;
        if (rowmode == 1) row = (nn >> 7) * 256 + (nn & 127);
        else if (rowmode == 2) row = (nn >> 7) * 256 + 128 + (nn & 127);
        else if (rowmode == 3) row = nn < 1024 ? nn : (nn < 2048 ? nn + 1024 : nn - 1024);
        else row = nn;
        *(u32x4*)(dst + (size_t)row * ldd + k0 + k8) = w; }
    __syncthreads();
}

__device__ __forceinline__ void weight_tile(const Params& P, int t, float* T) {
    unsigned char* ws = P.ws;
    {
        int j = t; const float* src; int ldsrc, nkt, nnt; bf16_t* dst; int ldd; const float* gain = nullptr; int rowmode = 0;
        if (j < 64) { const int gi = j >> 4; j &= 15; src = P.in[10] + (size_t)gi * 65536; ldsrc = 256; nkt = 4; nnt = 4; dst = (bf16_t*)(ws + O_WP) + (size_t)gi * 65536; ldd = 256; }
        else if ((j -= 64) < 2816) { const int q = j / 704; j %= 704; const int layer = q >> 1, up = q & 1; src = P.in[up ? 19 : 18] + (size_t)layer * 1024 * 2816; ldsrc = 2816; nkt = 16; nnt = 44;
            dst = (bf16_t*)(ws + O_WGU) + (size_t)layer * 5632 * 1024; ldd = 1024; gain = P.in[7] + layer * 1024; rowmode = 1 + up; }
        else if ((j -= 2816) < 1408) { const int layer = j / 704; j %= 704; src = P.in[20] + (size_t)layer * 2816 * 1024; ldsrc = 1024; nkt = 44; nnt = 16; dst = (bf16_t*)(ws + O_WD) + (size_t)layer * 1024 * 2816; ldd = 2816; }
        else if ((j -= 1408) < 512) { const int layer = j >> 8; j &= 255; src = P.in[22] + (size_t)layer * 1024 * 1024; ldsrc = 1024; nkt = 16; nnt = 16; dst = (bf16_t*)(ws + O_WPG) + (size_t)layer * 1024 * 1024; ldd = 1024; gain = P.in[8] + layer * 1024; }
        else if ((j -= 512) < 128) { const int layer = j >> 6; j &= 63; src = P.in[21] + (size_t)layer * 256 * 1024; ldsrc = 1024; nkt = 4; nnt = 16; dst = (bf16_t*)(ws + O_WPP) + (size_t)layer * 1024 * 256; ldd = 256; }
        else if ((j -= 128) < 768) { src = P.in[13]; ldsrc = GIN; nkt = 16; nnt = 48; dst = (bf16_t*)(ws + O_WIN); ldd = 1024; gain = P.in[6] + 1024; rowmode = 3; }
        else { j -= 768; src = P.in[17]; ldsrc = 1024; nkt = 16; nnt = 16; dst = (bf16_t*)(ws + O_WO); ldd = 1024; }
        const int kt = j / nnt, ntile = j % nnt; (void)nkt;
        transpose_tile(src, ldsrc, kt * 64, ntile * 64, dst, ldd, gain, rowmode, T);
    }
}
constexpr int N_EARLY = 3264, N_DEFER = 2688;
__device__ __forceinline__ int early_tile(int k) { if (k < 1472) return k; k -= 1472; if (k < 704) return 2880 + k; k -= 704; if (k < 256) return 4288 + k; k -= 256; if (k < 64) return 4800 + k; k -= 64; return 4928 + k; }
__device__ __forceinline__ int defer_tile(int k) { if (k < 1408) return 1472 + k; k -= 1408; if (k < 704) return 3584 + k; k -= 704; if (k < 256) return 4544 + k; k -= 256; if (k < 64) return 4864 + k; k -= 64; return 5696 + k; }
__device__ __forceinline__ void prep_weights(const Params& P, float* T) {
    unsigned char* ws = P.ws;
    for (int k = blockIdx.x; k < N_EARLY; k += gridDim.x) weight_tile(P, early_tile(k), T);
    if (gridDim.x != 256) for (int k = blockIdx.x; k < N_DEFER; k += gridDim.x) weight_tile(P, defer_tile(k), T);
    for (int i = blockIdx.x * NT + threadIdx.x; i < 16 * 1024; i += gridDim.x * NT) { const int n = i >> 10, k = i & 1023;
        const float v = P.in[13][(size_t)k * GIN + 3072 + n] * P.in[6][1024 + k]; ((bf16_t*)(ws + O_WGR))[i] = (bf16_t)(cvt_pk_bf16(v, 0.f) & 0xffffu); }
    for (int i = blockIdx.x * NT + threadIdx.x; i < 6 * M; i += gridDim.x * NT) ((float*)(ws + O_SSQ))[i] = 0.f;
}

__device__ __forceinline__ void convert_p(const Params& P, int layer, bf16_t* dst) {
    const f32x4* pp = (const f32x4*)(P.in[4] + (size_t)layer * MP_ROWS * PLE); const f32x4* ps = (const f32x4*)(P.in[5] + (size_t)layer * MS_ROWS * PLE);
    constexpr int n4 = M * PLE / 4, np4 = MP_ROWS * PLE / 4;
    const int stride = gridDim.x * NT;
    for (int i0 = blockIdx.x * NT + threadIdx.x; i0 < n4; i0 += 8 * stride) {
        f32x4 v[8];
#pragma unroll
        for (int j = 0; j < 8; ++j) { int i = i0 + j * stride; i = i < n4 ? i : n4 - 1; const f32x4* src = i < np4 ? pp + i : ps + (i - np4); v[j] = *src; }
#pragma unroll
        for (int j = 0; j < 8; ++j) { const int i = i0 + j * stride; if (i < n4) { u32x2 w; w.x = cvt_pk_bf16(v[j][0], v[j][1]); w.y = cvt_pk_bf16(v[j][2], v[j][3]); ((u32x2*)dst)[i] = w; } }
    }
}

template <int W> __device__ __forceinline__ void pool_diffs_w(const Params& P, float* lf) {
    const int tid = threadIdx.x, wid = tid >> 6, lane = tid & 63;
    bf16_t* Dm = (bf16_t*)(P.ws + O_DM);
    float* wsum = lf;
    float* rinv = lf + 128;
    for (int it = blockIdx.x; it < 256 + 16; it += gridDim.x) {
        const bool smp = it >= 256; const int s = smp ? it - 256 : it >> 6, t0 = smp ? 0 : (it & 63) * 64, ngrp = smp ? 2 : 5;
        const int ch = tid * 2; constexpr float iw = 1.0f / (float)W; const f32x2 gn = *(const f32x2*)(P.in[6] + ch);
        float r0[16], r1[16], run0 = 0.f, run1 = 0.f;
#pragma unroll
        for (int i = 0; i < 16; ++i) { r0[i] = 0.f; r1[i] = 0.f; }
        f32x2 xv[16], xn[16];
#define POOL_LOAD(dst, g_) do { _Pragma("unroll") for (int i = 0; i < 16; ++i) { const int rel = (g_) * 16 + i - 16, t = t0 + rel; \
                const float* src_ = smp ? (rel >= 0 ? P.in[1] + (size_t)(s * 16 + rel) * D : P.in[2] + (size_t)(s * 15 + (rel + 15 > 0 ? rel + 15 : 0)) * D) : P.in[0] + (size_t)(s * SEQ + (t > 0 ? t : 0)) * D; \
                f32x2 v = *(const f32x2*)(src_ + ch);                       \
                const bool ok_ = smp ? (rel >= -15) : (t >= 0); if (!ok_) v = (f32x2){0.f, 0.f}; \
                dst[i] = v; } } while (0)
        POOL_LOAD(xv, 0);
        for (int grp = 0; grp < ngrp; ++grp) {
            if (grp + 1 < ngrp) POOL_LOAD(xn, grp + 1);
            float q8[8], q4[4], q2[2], q1;
#pragma unroll
            for (int j = 0; j < 8; ++j) { const float e = xv[2 * j].x * xv[2 * j].x + xv[2 * j].y * xv[2 * j].y, o = xv[2 * j + 1].x * xv[2 * j + 1].x + xv[2 * j + 1].y * xv[2 * j + 1].y;
                const bool hi = lane & 1; q8[j] = (hi ? o : e) + __shfl_xor(hi ? e : o, 1); }
#pragma unroll
            for (int j = 0; j < 4; ++j) { const bool hi = lane & 2; q4[j] = (hi ? q8[2 * j + 1] : q8[2 * j]) + __shfl_xor(hi ? q8[2 * j] : q8[2 * j + 1], 2); }
#pragma unroll
            for (int j = 0; j < 2; ++j) { const bool hi = lane & 4; q2[j] = (hi ? q4[2 * j + 1] : q4[2 * j]) + __shfl_xor(hi ? q4[2 * j] : q4[2 * j + 1], 4); }
            { const bool hi = lane & 8; q1 = (hi ? q2[1] : q2[0]) + __shfl_xor(hi ? q2[0] : q2[1], 8); }
            q1 += __shfl_xor(q1, 16); q1 += __shfl_xor(q1, 32);
            if (lane < 16) wsum[wid * 16 + lane] = q1;
            __syncthreads();
            if (tid < 16) { float tot = 0.f;
#pragma unroll
                for (int w8 = 0; w8 < 8; ++w8) tot += wsum[w8 * 16 + tid];
                rinv[tid] = rinv_of(tot); }
            __syncthreads();
#pragma unroll
            for (int i = 0; i < 16; ++i) { const int rel = grp * 16 + i - 16, t = t0 + rel;
                float a0, a1;
                if (smp && rel < 0) { a0 = xv[i].x; a1 = xv[i].y; } else { const float ri = rinv[i]; a0 = xv[i].x * ri * gn.x; a1 = xv[i].y * ri * gn.y; }
                run0 += a0 - r0[(i - W) & 15]; run1 += a1 - r1[(i - W) & 15];
                r0[i] = a0; r1[i] = a1;
                if (rel >= 0) {
                    const float s0 = run0, s1 = run1;
                    const float ic = (smp || t + 1 >= W) ? iw : 1.0f / (float)(t + 1);
                    const float d0 = s0 * ic - a0, d1 = s1 * ic - a1;
                    const size_t grow = smp ? (size_t)MP_ROWS + s * 16 + rel : (size_t)s * SEQ + t;
                    *(unsigned*)(Dm + grow * D + ch) = cvt_pk_bf16(d0, d1);
                    if (smp) { if (rel >= 1) *(f32x2*)(P.out + OUT_PSS + (size_t)(s * 15 + rel - 1) * D + ch) = (f32x2){a0, a1}; }
                    else if (t >= SEQ - 15) *(f32x2*)(P.out + OUT_PSP + (size_t)(s * 15 + t - (SEQ - 15)) * D + ch) = (f32x2){a0, a1};
                } }
#pragma unroll
            for (int i = 0; i < 16; ++i) xv[i] = xn[i];
        }
#undef POOL_LOAD
        __syncthreads();
    }
}
__device__ __forceinline__ void pool_diffs(const Params& P, float* lf) {
    const int g = __builtin_amdgcn_readfirstlane(threadIdx.x >> 7);
    if (g == 0) pool_diffs_w<2>(P, lf); else if (g == 1) pool_diffs_w<4>(P, lf); else if (g == 2) pool_diffs_w<8>(P, lf); else pool_diffs_w<16>(P, lf);
}

__device__ __forceinline__ void gr_pass(const bf16_t* hb, const bf16_t* WgrT, const float* ssq_in, float* gr) {
    const int lane = threadIdx.x & 63, wid = threadIdx.x >> 6, fr = lane & 15, fq = lane >> 4;
    for (int gidx = blockIdx.x * 8 + wid; gidx < M / 16; gidx += gridDim.x * 8) {
        const int r0 = gidx * 16; f32x4 acc = (f32x4){0.f, 0.f, 0.f, 0.f};
        const bf16_t* ap = hb + (size_t)(r0 + fr) * D + 8 * fq; const bf16_t* bp = WgrT + (size_t)fr * D + 8 * fq;
#pragma unroll 8
        for (int s = 0; s < 32; ++s) { const bf16x8 a = *(const bf16x8*)(ap + 32 * s), b = *(const bf16x8*)(bp + 32 * s); acc = __builtin_amdgcn_mfma_f32_16x16x32_bf16(a, b, acc, 0, 0, 0); }
#pragma unroll
        for (int j = 0; j < 4; ++j) { const int r = r0 + 4 * fq + j; gr[(size_t)r * 16 + fr] = acc[j] * rinv_of(ssq_in[r]); }
    }
}

struct Item { int row0, L, h, j; };
__device__ __forceinline__ Item decode_item(int it) { Item I; if (it < 1024) { const int b = it >> 8; I.h = (it >> 6) & 3; I.row0 = b * SEQ + (it & 63) * 64; I.L = 64; } else { const int j = it - 1024; I.h = j & 3; I.row0 = MP_ROWS + (j >> 2) * 16; I.L = 16; } I.j = it; return I; }

constexpr int L_GRS = 0;
constexpr int L_BSH = 4096;
constexpr int L_QT = 36864;
constexpr int L_KT = 38912;
constexpr int L_QD = 38912;
constexpr int L_KIN = 56320;
constexpr int L_PSH = 73728;
constexpr int L_SSQ = 82944;

__device__ __forceinline__ void compute_b(const Params& P, const Item& I, unsigned char* lds) {
    const int tid = threadIdx.x; float* grs = (float*)(lds + L_GRS); float* bsh = (float*)(lds + L_BSH); float* qt = (float*)(lds + L_QT);
    const float* gr = (const float*)(P.ws + O_GR);
    if (tid < 256) { const int t = tid >> 2, tc = t < I.L ? t : I.L - 1; f32x4 v = *(const f32x4*)(gr + (size_t)(I.row0 + tc) * 16 + (tid & 3) * 4); if (t >= I.L) v = (f32x4){0.f, 0.f, 0.f, 0.f}; *(f32x4*)(grs + tid * 4) = v; }
    const int dk = tid & 127, tq = tid >> 7;
    float wc[16];
#pragma unroll
    for (int r = 0; r < 16; ++r) wc[r] = P.in[14][r * KEYD + I.h * DK + dk];
    const float bias = P.in[15][I.h * DK + dk];
    __syncthreads();
    float bl[16]; float run = 0.f;
#pragma unroll
    for (int i = 0; i < 16; ++i) { const int t = tq * 16 + i; float a = bias;
#pragma unroll
        for (int r = 0; r < 16; ++r) a += grs[t * 16 + r] * wc[r];
        const float ls = fminf(a, 0.f) - __logf(1.0f + __expf(-fabsf(a)));
        run += (t < I.L) ? ls * (1.0f / 16.0f) : 0.f; bl[i] = run; }
    qt[tq * 128 + dk] = run;
    __syncthreads();
    float off = 0.f;
#pragma unroll
    for (int q = 0; q < 3; ++q) if (q < tq) off += qt[q * 128 + dk];
#pragma unroll
    for (int i = 0; i < 16; ++i) bsh[(tq * 16 + i) * 128 + dk] = bl[i] + off;
    __syncthreads();
}

__device__ __forceinline__ void gla_g1(const Params& P, unsigned char* lds) {
    const int tid = threadIdx.x, wid = tid >> 6, lane = tid & 63, fr = lane & 15, fq = lane >> 4;
    const bf16_t* kg = (const bf16_t*)(P.ws + O_K); const bf16_t* vT = (const bf16_t*)(P.ws + O_VT);
    bf16_t* KVT = (bf16_t*)(P.ws + O_KVT); float* dec = (float*)(P.ws + O_DEC);
    const float* bsh = (const float*)(lds + L_BSH); bf16_t* kT = (bf16_t*)(lds + L_KT);
    for (int it = blockIdx.x; it < NITEM; it += gridDim.x) {
        const Item I = decode_item(it);
        compute_b(P, I, lds);
        { const int dk = tid & 127, tq = tid >> 7; const float blast = bsh[63 * 128 + dk]; float ke[16];
            bf16_t kraw[16];
#pragma unroll
            for (int i = 0; i < 16; ++i) { const int t = tq * 16 + i, tc = t < I.L ? t : I.L - 1; kraw[i] = kg[(size_t)(I.row0 + tc) * KEYD + I.h * DK + dk]; }
#pragma unroll
            for (int i = 0; i < 16; ++i) { const int t = tq * 16 + i; const float kv = bf1(kraw[i]) * __expf(blast - bsh[t * 128 + dk]); ke[i] = t < I.L ? kv : 0.f; }
            u32x4 w0, w1; w0.x = cvt_pk_bf16(ke[0], ke[1]); w0.y = cvt_pk_bf16(ke[2], ke[3]); w0.z = cvt_pk_bf16(ke[4], ke[5]); w0.w = cvt_pk_bf16(ke[6], ke[7]);
            w1.x = cvt_pk_bf16(ke[8], ke[9]); w1.y = cvt_pk_bf16(ke[10], ke[11]); w1.z = cvt_pk_bf16(ke[12], ke[13]); w1.w = cvt_pk_bf16(ke[14], ke[15]);
            *(u32x4*)(kT + dk * 72 + tq * 16) = w0; *(u32x4*)(kT + dk * 72 + tq * 16 + 8) = w1;
            if (tq == 0) dec[(size_t)it * 128 + dk] = __expf(blast); }
        __syncthreads();
        f32x4 acc[8][2];
#pragma unroll
        for (int mt = 0; mt < 8; ++mt) { acc[mt][0] = (f32x4){0.f, 0.f, 0.f, 0.f}; acc[mt][1] = (f32x4){0.f, 0.f, 0.f, 0.f}; }
#pragma unroll
        for (int s = 0; s < 2; ++s) { const int t8 = 32 * s + 8 * fq;
            if (32 * s < I.L) {
                bf16x8 bfr[2];
#pragma unroll
                for (int nt = 0; nt < 2; ++nt) { const int tc = t8 < I.L ? t8 : 0; bfr[nt] = *(const bf16x8*)(vT + (size_t)(I.h * DV + 32 * wid + 16 * nt + fr) * MPAD + I.row0 + tc); if (t8 >= I.L) bfr[nt] = (bf16x8){0, 0, 0, 0, 0, 0, 0, 0}; }
#pragma unroll
                for (int mt = 0; mt < 8; ++mt) { const bf16x8 a = *(const bf16x8*)(kT + (16 * mt + fr) * 72 + t8);
                    acc[mt][0] = __builtin_amdgcn_mfma_f32_16x16x32_bf16(a, bfr[0], acc[mt][0], 0, 0, 0); acc[mt][1] = __builtin_amdgcn_mfma_f32_16x16x32_bf16(a, bfr[1], acc[mt][1], 0, 0, 0); } } }
        if (it < 1024) {
#pragma unroll
            for (int mt = 0; mt < 8; ++mt)
#pragma unroll
                for (int nt = 0; nt < 2; ++nt) { u32x2 w; w.x = cvt_pk_bf16(acc[mt][nt][0], acc[mt][nt][1]); w.y = cvt_pk_bf16(acc[mt][nt][2], acc[mt][nt][3]);
                    *(u32x2*)(KVT + ((size_t)it * 256 + 32 * wid + 16 * nt + fr) * 128 + 16 * mt + 4 * fq) = w; }
        } else {
            const int j = it - 1024; const float* s0 = P.in[3] + (size_t)j * DK * DV; float* fin = P.out + OUT_GSS + (size_t)j * DK * DV;
#pragma unroll
            for (int mt = 0; mt < 8; ++mt) { const int dk0 = 16 * mt + 4 * fq;
                f32x4 dd;
#pragma unroll
                for (int r = 0; r < 4; ++r) dd[r] = __expf(bsh[63 * 128 + dk0 + r]);
#pragma unroll
                for (int nt = 0; nt < 2; ++nt) { const int dv = 32 * wid + 16 * nt + fr; f32x4 sv;
#pragma unroll
                    for (int r = 0; r < 4; ++r) sv[r] = s0[(size_t)(dk0 + r) * DV + dv];
                    u32x2 w; w.x = cvt_pk_bf16(sv[0], sv[1]); w.y = cvt_pk_bf16(sv[2], sv[3]);
                    *(u32x2*)(KVT + ((size_t)it * 256 + dv) * 128 + dk0) = w;
#pragma unroll
                    for (int r = 0; r < 4; ++r) fin[(size_t)(dk0 + r) * DV + dv] = dd[r] * sv[r] + acc[mt][nt][r]; } }
        }
        __syncthreads();
    }
}

__device__ __forceinline__ void gla_g2(const Params& P, unsigned char* lds) {
    const int tid = threadIdx.x; bf16_t* KVT = (bf16_t*)(P.ws + O_KVT); const float* dec = (const float*)(P.ws + O_DEC); float* tile = (float*)lds;
    const int dvl = tid >> 5, dk4 = (tid & 31) * 4, odk = tid >> 2, odv4 = (tid & 3) * 4;
    for (int u = blockIdx.x; u < 256; u += gridDim.x) {
        const int bh = u >> 4, dvb = u & 15, dv = dvb * 16 + dvl; f32x4 S = (f32x4){0.f, 0.f, 0.f, 0.f};
        for (int cb = 0; cb < 8; ++cb) {
            u32x2 kv[8]; f32x4 d[8];
#pragma unroll
            for (int j = 0; j < 8; ++j) { const int it = bh * 64 + cb * 8 + j; kv[j] = *(const u32x2*)(KVT + ((size_t)it * 256 + dv) * 128 + dk4); d[j] = *(const f32x4*)(dec + (size_t)it * 128 + dk4); }
#pragma unroll
            for (int j = 0; j < 8; ++j) { const int it = bh * 64 + cb * 8 + j; u32x2 w; w.x = cvt_pk_bf16(S[0], S[1]); w.y = cvt_pk_bf16(S[2], S[3]);
                *(u32x2*)(KVT + ((size_t)it * 256 + dv) * 128 + dk4) = w;
                S[0] = d[j][0] * S[0] + bf_lo(kv[j].x); S[1] = d[j][1] * S[1] + bf_hi(kv[j].x); S[2] = d[j][2] * S[2] + bf_lo(kv[j].y); S[3] = d[j][3] * S[3] + bf_hi(kv[j].y); }
        }
        __syncthreads();
#pragma unroll
        for (int i = 0; i < 4; ++i) tile[(dk4 + i) * 17 + dvl] = S[i];
        __syncthreads();
        { f32x4 o; o[0] = tile[odk * 17 + odv4]; o[1] = tile[odk * 17 + odv4 + 1]; o[2] = tile[odk * 17 + odv4 + 2]; o[3] = tile[odk * 17 + odv4 + 3];
            *(f32x4*)(P.out + OUT_GSP + ((size_t)bh * 128 + odk) * 256 + dvb * 16 + odv4) = o; }
    }
}

__device__ __forceinline__ void gla_g3(const Params& P, unsigned char* lds) {
    const int tid = threadIdx.x, wid = tid >> 6, lane = tid & 63, fr = lane & 15, fq = lane >> 4;
    const bf16_t* qg = (const bf16_t*)(P.ws + O_Q); const bf16_t* kg = (const bf16_t*)(P.ws + O_K); const bf16_t* gg = (const bf16_t*)(P.ws + O_G);
    const bf16_t* vT = (const bf16_t*)(P.ws + O_VT); const bf16_t* SpT = (const bf16_t*)(P.ws + O_KVT); bf16_t* og = (bf16_t*)(P.ws + O_OG);
    const float* bsh = (const float*)(lds + L_BSH); bf16_t* qd = (bf16_t*)(lds + L_QD); bf16_t* kin = (bf16_t*)(lds + L_KIN); bf16_t* Psh = (bf16_t*)(lds + L_PSH); float* ssh = (float*)(lds + L_SSQ);
    bf16x8 sfp[4][2];
#define G3_LOAD_S(it_) do { _Pragma("unroll") for (int s_ = 0; s_ < 4; ++s_) _Pragma("unroll") for (int nt_ = 0; nt_ < 2; ++nt_) \
        sfp[s_][nt_] = *(const bf16x8*)(SpT + ((size_t)(it_) * 256 + 32 * wid + 16 * nt_ + fr) * 128 + 32 * s_ + 8 * fq); } while (0)
    if ((int)blockIdx.x < NITEM) G3_LOAD_S(blockIdx.x);
    for (int it = blockIdx.x; it < NITEM; it += gridDim.x) {
        const Item I = decode_item(it);
        compute_b(P, I, lds);
#pragma unroll
        for (int p = 0; p < 2; ++p) { const int idx = tid + p * NT, t = idx >> 4, c8 = (idx & 15) * 8; u32x4 qo = (u32x4){0u, 0u, 0u, 0u}, ko = (u32x4){0u, 0u, 0u, 0u};
            const int tcl = t < I.L ? t : I.L - 1; const u32x4 qw = *(const u32x4*)(qg + (size_t)(I.row0 + tcl) * KEYD + I.h * DK + c8), kw = *(const u32x4*)(kg + (size_t)(I.row0 + tcl) * KEYD + I.h * DK + c8);
            if (t < I.L) {
                const f32x4 b0 = *(const f32x4*)(bsh + t * 128 + c8), b1 = *(const f32x4*)(bsh + t * 128 + c8 + 4);
                float e[8], ei[8];
#pragma unroll
                for (int j = 0; j < 4; ++j) { e[j] = __expf(b0[j]); e[4 + j] = __expf(b1[j]); ei[j] = __expf(-b0[j]); ei[4 + j] = __expf(-b1[j]); }
                qo.x = cvt_pk_bf16(bf_lo(qw.x) * e[0], bf_hi(qw.x) * e[1]); qo.y = cvt_pk_bf16(bf_lo(qw.y) * e[2], bf_hi(qw.y) * e[3]); qo.z = cvt_pk_bf16(bf_lo(qw.z) * e[4], bf_hi(qw.z) * e[5]); qo.w = cvt_pk_bf16(bf_lo(qw.w) * e[6], bf_hi(qw.w) * e[7]);
                ko.x = cvt_pk_bf16(bf_lo(kw.x) * ei[0], bf_hi(kw.x) * ei[1]); ko.y = cvt_pk_bf16(bf_lo(kw.y) * ei[2], bf_hi(kw.y) * ei[3]); ko.z = cvt_pk_bf16(bf_lo(kw.z) * ei[4], bf_hi(kw.z) * ei[5]); ko.w = cvt_pk_bf16(bf_lo(kw.w) * ei[6], bf_hi(kw.w) * ei[7]); }
            *(u32x4*)(qd + t * 136 + c8) = qo; *(u32x4*)(kin + t * 136 + c8) = ko; }
        __syncthreads();
        { const int lt = wid >> 1;
#pragma unroll
            for (int q = 0; q < 2; ++q) { const int mt = 2 * (wid & 1) + q; f32x4 a4 = (f32x4){0.f, 0.f, 0.f, 0.f};
                if (mt <= lt) {
#pragma unroll
                    for (int s = 0; s < 4; ++s) { const bf16x8 a = *(const bf16x8*)(qd + (16 * lt + fr) * 136 + 32 * s + 8 * fq), b = *(const bf16x8*)(kin + (16 * mt + fr) * 136 + 32 * s + 8 * fq);
                        a4 = __builtin_amdgcn_mfma_f32_16x16x32_bf16(a, b, a4, 0, 0, 0); } }
                const int mcol = 16 * mt + fr;
#pragma unroll
                for (int j = 0; j < 4; ++j) { const int l = 16 * lt + 4 * fq + j; const float pv = (mcol <= l) ? a4[j] : 0.f; Psh[l * 72 + mcol] = (bf16_t)(cvt_pk_bf16(pv, 0.f) & 0xffffu); } } }
        __syncthreads();
        f32x4 acc[2][4];
#pragma unroll
        for (int nt = 0; nt < 2; ++nt)
#pragma unroll
            for (int lt = 0; lt < 4; ++lt) acc[nt][lt] = (f32x4){0.f, 0.f, 0.f, 0.f};
#pragma unroll
        for (int s = 0; s < 2; ++s) { const int t8 = 32 * s + 8 * fq;
            if (32 * s < I.L) {
                bf16x8 vf[2];
#pragma unroll
                for (int nt = 0; nt < 2; ++nt) { const int tc = t8 < I.L ? t8 : 0; vf[nt] = *(const bf16x8*)(vT + (size_t)(I.h * DV + 32 * wid + 16 * nt + fr) * MPAD + I.row0 + tc); if (t8 >= I.L) vf[nt] = (bf16x8){0, 0, 0, 0, 0, 0, 0, 0}; }
#pragma unroll
                for (int lt = 0; lt < 4; ++lt) { const bf16x8 pf = *(const bf16x8*)(Psh + (16 * lt + fr) * 72 + t8);
                    acc[0][lt] = __builtin_amdgcn_mfma_f32_16x16x32_bf16(vf[0], pf, acc[0][lt], 0, 0, 0); acc[1][lt] = __builtin_amdgcn_mfma_f32_16x16x32_bf16(vf[1], pf, acc[1][lt], 0, 0, 0); } } }
#pragma unroll
        for (int s = 0; s < 4; ++s) { const int k8 = 32 * s + 8 * fq;
#pragma unroll
            for (int lt = 0; lt < 4; ++lt) { const bf16x8 qf = *(const bf16x8*)(qd + (16 * lt + fr) * 136 + k8);
                acc[0][lt] = __builtin_amdgcn_mfma_f32_16x16x32_bf16(sfp[s][0], qf, acc[0][lt], 0, 0, 0); acc[1][lt] = __builtin_amdgcn_mfma_f32_16x16x32_bf16(sfp[s][1], qf, acc[1][lt], 0, 0, 0); } }
        if (it + (int)gridDim.x < NITEM) G3_LOAD_S(it + gridDim.x);
#pragma unroll
        for (int lt = 0; lt < 4; ++lt) { float ss = 0.f;
#pragma unroll
            for (int nt = 0; nt < 2; ++nt) ss += (acc[nt][lt][0] * acc[nt][lt][0] + acc[nt][lt][1] * acc[nt][lt][1]) + (acc[nt][lt][2] * acc[nt][lt][2] + acc[nt][lt][3] * acc[nt][lt][3]);
            ss += __shfl_xor(ss, 16); ss += __shfl_xor(ss, 32);
            if (fq == 0) ssh[wid * 64 + 16 * lt + fr] = ss; }
        u32x2 gwp[4][2];
#pragma unroll
        for (int lt = 0; lt < 4; ++lt)
#pragma unroll
            for (int nt = 0; nt < 2; ++nt) { const int l = 16 * lt + fr, lc = l < I.L ? l : I.L - 1;
                gwp[lt][nt] = *(const u32x2*)(gg + (size_t)(I.row0 + lc) * D + I.h * DV + 32 * wid + 16 * nt + 4 * fq); }
        __syncthreads();
#pragma unroll
        for (int lt = 0; lt < 4; ++lt) { const int l = 16 * lt + fr;
            if (l < I.L) { float tot = 0.f;
#pragma unroll
                for (int w8 = 0; w8 < 8; ++w8) tot += ssh[w8 * 64 + l];
                const float ro = rsqrtf(tot * (1.0f / 256.0f) + EPS);
#pragma unroll
                for (int nt = 0; nt < 2; ++nt) { const int dvh = 32 * wid + 16 * nt + 4 * fq; const size_t off = (size_t)(I.row0 + l) * D + I.h * DV + dvh;
                    const u32x2 gw = gwp[lt][nt]; const f32x4 nw = *(const f32x4*)(P.in[16] + dvh);
                    const float o0 = acc[nt][lt][0] * ro * nw[0] * siluf_(bf_lo(gw.x)), o1 = acc[nt][lt][1] * ro * nw[1] * siluf_(bf_hi(gw.x));
                    const float o2 = acc[nt][lt][2] * ro * nw[2] * siluf_(bf_lo(gw.y)), o3 = acc[nt][lt][3] * ro * nw[3] * siluf_(bf_hi(gw.y));
                    u32x2 w; w.x = cvt_pk_bf16(o0, o1); w.y = cvt_pk_bf16(o2, o3); *(u32x2*)(og + off) = w; } } }
        __syncthreads();
    }
}

__device__ __forceinline__ void final_norm(const Params& P, float* dst, int row_lo) {
    float* h = P.out + OUT_Y; const float* ssq = (const float*)(P.ws + O_SSQ) + 5 * M; const float* nf = P.in[9];
    constexpr int n4 = M * D / 4; const int stride = gridDim.x * NT;
    for (int i0 = row_lo * (D / 4) + blockIdx.x * NT + threadIdx.x; i0 < n4; i0 += 4 * stride) {
        f32x4 v[4];
#pragma unroll
        for (int j = 0; j < 4; ++j) { const int i = i0 + j * stride; v[j] = (f32x4){0.f, 0.f, 0.f, 0.f}; if (i < n4) v[j] = ((const f32x4*)h)[i]; }
#pragma unroll
        for (int j = 0; j < 4; ++j) { const int i = i0 + j * stride; if (i < n4) { const int r = i >> 8, c4 = (i & 255) * 4; const float ri = rinv_of(ssq[r]); const f32x4 g = *(const f32x4*)(nf + c4); ((f32x4*)dst)[i] = v[j] * ri * g; } }
    }
}
__device__ __forceinline__ void fused_final_tile(const Params& P, int pm, int pn, unsigned* cnt, unsigned char* lds_f) {
    const int tid = threadIdx.x;
    asm volatile("s_waitcnt vmcnt(0)" ::: "memory");
    __syncthreads();
    if (tid == 0) {
        __hip_atomic_fetch_add(cnt + 16 * pm, 1u, __ATOMIC_RELAXED, __HIP_MEMORY_SCOPE_AGENT);
        unsigned sp = 0;
        while (__hip_atomic_load(cnt + 16 * pm, __ATOMIC_RELAXED, __HIP_MEMORY_SCOPE_AGENT) < 4u) { __builtin_amdgcn_s_sleep(2); if (++sp > (1u << 22)) break; }
    }
    __syncthreads();
    float* h = P.out + OUT_Y; float* ssq = (float*)(P.ws + O_SSQ) + 5 * M; const float* nf = P.in[9];
    float* rs = (float*)lds_f;
    if (tid < 256) rs[tid] = rinv_of(__hip_atomic_load(ssq + pm * 256 + tid, __ATOMIC_RELAXED, __HIP_MEMORY_SCOPE_AGENT));
    __syncthreads();
    const int c4 = (tid & 63) * 4; const f32x4 g = *(const f32x4*)(nf + pn * 256 + c4);
    for (int i0 = 0; i0 < 32; i0 += 8) {
        f32x4 v[8];
#pragma unroll
        for (int j = 0; j < 8; ++j) { const int row = (i0 + j) * 8 + (tid >> 6); v[j] = *(const f32x4*)(h + (size_t)(pm * 256 + row) * D + pn * 256 + c4); }
#pragma unroll
        for (int j = 0; j < 8; ++j) { const int row = (i0 + j) * 8 + (tid >> 6); *(f32x4*)(h + (size_t)(pm * 256 + row) * D + pn * 256 + c4) = v[j] * rs[row] * g; } }
    __syncthreads();
}

__device__ __forceinline__ void fused_final_sample(const Params& P, int rt, int ct, unsigned* cnt) {
    const int tid = threadIdx.x;
    asm volatile("s_waitcnt vmcnt(0)" ::: "memory");
    __syncthreads();
    if (tid == 0) {
        __hip_atomic_fetch_add(cnt + 16 * rt, 1u, __ATOMIC_RELAXED, __HIP_MEMORY_SCOPE_AGENT);
        unsigned sp = 0;
        while (__hip_atomic_load(cnt + 16 * rt, __ATOMIC_RELAXED, __HIP_MEMORY_SCOPE_AGENT) < 32u) { __builtin_amdgcn_s_sleep(2); if (++sp > (1u << 22)) break; }
    }
    __syncthreads();
    if (tid < 256) { float* h = P.out + OUT_Y; float* ssq = (float*)(P.ws + O_SSQ) + 5 * M; const float* nf = P.in[9];
        const int r = MP_ROWS + 32 * rt + (tid >> 3), c = 32 * ct + (tid & 7) * 4;
        const float ri = rinv_of(__hip_atomic_load(ssq + r, __ATOMIC_RELAXED, __HIP_MEMORY_SCOPE_AGENT));
        float* hp = h + (size_t)r * D + c; f32x4 v = *(const f32x4*)hp; const f32x4 g = *(const f32x4*)(nf + c); *(f32x4*)hp = v * ri * g; }
}

__global__ void __launch_bounds__(NT, 2) fwd_kernel(Params P) {
    extern __shared__ __attribute__((aligned(16))) unsigned char lds[];
    cg::grid_group grid = cg::this_grid();
    LAS unsigned char* ldsl = (LAS unsigned char*)lds;
    unsigned char* ws = P.ws;
    const int G = gridDim.x, bx = blockIdx.x;
    float* h = P.out + OUT_Y;
    bf16_t* hbA = (bf16_t*)(ws + O_HBA); bf16_t* hbB = (bf16_t*)(ws + O_HBB);
    float* ssq = (float*)(ws + O_SSQ);
    bf16_t* act = (bf16_t*)(ws + O_ACT); bf16_t* pp = (bf16_t*)(ws + O_PP);
    const int lo = P.ph_lo, hi = (gridDim.x == 256 && P.ph_hi == 14) ? 13 : P.ph_hi;
#define STAGGER() do { const int ns_ = (bx >> 3) & 3; for (int i_ = 0; i_ < ns_; ++i_) __builtin_amdgcn_s_sleep(31); } while (0)
    if (threadIdx.x < 4) ((unsigned*)(lds + LDS_MAIN))[threadIdx.x] = 0u;
    __syncthreads();
    const XcdBarrier xbar = xcd_barrier_post((unsigned*)(ws + O_BAR), (volatile LAS unsigned*)(ldsl + LDS_MAIN));
    if (lo > 1000) grid.sync();
#define GRID_SYNC() xcd_barrier(xbar)
#ifndef DUPMASK
#define DUPMASK 0
#endif
#define DUP(k) (((DUPMASK) >> (k)) & 1)
#define PHASE(k, ...) if (EN(k) && lo <= (k) && (k) < hi) { constexpr bool dup_ = false; (void)dup_; __VA_ARGS__ if ((k) + 1 < hi) GRID_SYNC(); } if (DUP(k) && lo <= (k) && (k) < hi) { constexpr bool dup_ = true; (void)dup_; __VA_ARGS__ GRID_SYNC(); }
    PHASE(0,
        pool_diffs(P, (float*)lds);
        __syncthreads();
        convert_p(P, 0, (bf16_t*)(ws + O_PB0));
        prep_weights(P, (float*)lds);
    )
    PHASE(1,
        { pg8::Gemm g{(const bf16_t*)(ws + O_DM), (const bf16_t*)(ws + O_WP), D, 256, 256, 256}; pg8::StaticOrder S; S.init(64, 4, G, bx);
          EpiPool E{P.in[0], P.in[1], h, hbA, P.in[11], P.in[12], ssq + (dup_ ? 6 : 0) * M}; pg8::gemm_phase(ldsl, g, S, E);
          small_gemm(lds, g.A, D, g.Bt, 256, 256, 32, 256, E); }
    )
    PHASE(2,
        { pg8::Gemm g{hbA, (const bf16_t*)(ws + O_WGU), D, D, D, 0}; pg8::StaticOrder S; S.init(65, 22, G, bx);
          EpiGU E{act, ssq + 0 * M}; pg8::gemm_phase(ldsl, g, S, E); }
        if (G == 256 ? bx >= 150 : true) { const int gs = G == 256 ? 106 : G, gc = G == 256 ? bx - 150 : bx;
          pg8::Gemm g{(const bf16_t*)(ws + O_PB0), (const bf16_t*)(ws + O_WPP), PLE, PLE, PLE, 0}; pg8::StaticOrder S; S.init(64, 4, gs, gc);
          EpiBf E{pp, D}; pg8::gemm_phase(ldsl, g, S, E);
          small_gemm(lds, g.A, PLE, g.Bt, PLE, PLE, 32, 0, E, gc, gs); }
    )
    PHASE(3,
        pg8::Gemm g{act, (const bf16_t*)(ws + O_WD), DFF, DFF, DFF, 0}; pg8::StaticOrder S; S.init(64, 4, G, bx);
        EpiRes E{h, hbB, ssq + (dup_ ? 6 : 1) * M, dup_ ? 0.f : 1.f}; pg8::gemm_phase(ldsl, g, S, E);
        small_gemm(lds, g.A, DFF, g.Bt, DFF, DFF, 32, 0, E);
    )
    PHASE(4,
        pg8::Gemm g{hbB, (const bf16_t*)(ws + O_WPG), D, D, D, 0}; pg8::StaticOrder S; S.init(64, 4, G, bx);
        EpiPle E{h, hbA, pp, ssq + 1 * M, ssq + (dup_ ? 6 : 2) * M, dup_ ? 0.f : 1.f}; pg8::gemm_phase(ldsl, g, S, E);
        small_gemm(lds, g.A, D, g.Bt, D, D, 32, 0, E);
    )
    PHASE(5,
        gr_pass(hbA, (const bf16_t*)(ws + O_WGR), ssq + 2 * M, (float*)(ws + O_GR));
        __syncthreads();
        { pg8::Gemm g{hbA, (const bf16_t*)(ws + O_WIN), D, D, D, 0}; pg8::StaticOrder S; S.init(64, 8, G, bx);
          EpiQKG E{(bf16_t*)(ws + O_Q), (bf16_t*)(ws + O_K), (bf16_t*)(ws + O_G), ssq + 2 * M}; pg8::gemm_phase(ldsl, g, S, E);
          small_gemm(lds, g.A, D, g.Bt, D, D, 64, 0, E); }
        { pg8::Gemm g{(const bf16_t*)(ws + O_WIN) + (size_t)2048 * 1024, hbA, D, D, D, 0}; pg8::StaticOrder S; S.init(4, 64, G, bx);
          EpiVT E{(bf16_t*)(ws + O_VT), ssq + 2 * M}; pg8::gemm_phase(ldsl, g, S, E);
          small_gemm(lds, hbA, D, g.A, D, D, 32, 0, E); }
    )
    PHASE(6, gla_g1(P, lds); if (!dup_ && G == 256 && bx >= 64) { __syncthreads(); for (int k = bx - 64; k < N_DEFER; k += 384) weight_tile(P, defer_tile(k), (float*)lds); } )
    PHASE(7, gla_g2(P, lds); )
    PHASE(8, gla_g3(P, lds); if (!dup_ && G == 256 && bx >= 64) { __syncthreads(); for (int k = 192 + bx - 64; k < N_DEFER; k += 384) weight_tile(P, defer_tile(k), (float*)lds); } )
    PHASE(9,
        pg8::Gemm g{(const bf16_t*)(ws + O_OG), (const bf16_t*)(ws + O_WO), D, D, D, 0}; pg8::StaticOrder S; S.init(64, 4, G, bx);
        EpiRes E{h, hbB, ssq + (dup_ ? 6 : 3) * M, dup_ ? 0.f : 1.f}; pg8::gemm_phase(ldsl, g, S, E);
        small_gemm(lds, g.A, D, g.Bt, D, D, 32, 0, E);
        convert_p(P, 1, (bf16_t*)(ws + O_PB1));
    )
    PHASE(10,
        { pg8::Gemm g{hbB, (const bf16_t*)(ws + O_WGU) + (size_t)5632 * 1024, D, D, D, 0}; pg8::StaticOrder S; S.init(65, 22, G, bx);
          EpiGU E{act, ssq + 3 * M}; pg8::gemm_phase(ldsl, g, S, E); }
        if (G == 256 ? bx >= 150 : true) { const int gs = G == 256 ? 106 : G, gc = G == 256 ? bx - 150 : bx;
          pg8::Gemm g{(const bf16_t*)(ws + O_PB1), (const bf16_t*)(ws + O_WPP) + (size_t)1024 * 256, PLE, PLE, PLE, 0}; pg8::StaticOrder S; S.init(64, 4, gs, gc);
          EpiBf E{pp, D}; pg8::gemm_phase(ldsl, g, S, E);
          small_gemm(lds, g.A, PLE, g.Bt, PLE, PLE, 32, 0, E, gc, gs); }
    )
    PHASE(11,
        { pg8::Gemm g{act, (const bf16_t*)(ws + O_WD) + (size_t)1024 * 2816, DFF, DFF, DFF, 0}; pg8::StaticOrder S; S.init(64, 4, G, bx);
          EpiRes E{h, hbA, ssq + (dup_ ? 6 : 4) * M, dup_ ? 0.f : 1.f}; pg8::gemm_phase(ldsl, g, S, E);
          small_gemm(lds, g.A, DFF, g.Bt, DFF, DFF, 32, 0, E); }
    )
    PHASE(12,
        pg8::Gemm g{hbA, (const bf16_t*)(ws + O_WPG) + (size_t)1024 * 1024, D, D, D, 0}; pg8::StaticOrder S; S.init(64, 4, G, bx);
        EpiPle E{h, hbB, pp, ssq + 4 * M, ssq + (dup_ ? 6 : 5) * M, dup_ ? 0.f : 1.f}; pg8::gemm_phase(ldsl, g, S, E);
        if (!dup_ && G == 256) { pg8::Unit u; if (S.next(0, u)) fused_final_tile(P, u.pm, u.pn, (unsigned*)(ws + O_BAR) + 4096, lds); }
        small_gemm(lds, g.A, D, g.Bt, D, D, 32, 0, E);
        if (!dup_ && G == 256) fused_final_sample(P, bx & 7, bx >> 3, (unsigned*)(ws + O_BAR) + 4096 + 16 * 64);
    )
#ifdef EXTRA_SYNCS
    for (int i_ = 0; i_ < EXTRA_SYNCS; ++i_) GRID_SYNC();
#endif
    if (G != 256) { PHASE(13, final_norm(P, dup_ ? (float*)(ws + O_ACT) : P.out + OUT_Y, 0); ) }
}

extern "C" void kernel_launch(void* const* d_in, const int* in_sizes, int n_in, void* d_out, int out_size, void* d_ws, size_t ws_size, hipStream_t stream) {
    static int grid_blocks = 0;
    if (!grid_blocks) {
        int dev = 0, cus = 0, per_cu = 0;
        hipGetDevice(&dev);
        hipDeviceGetAttribute(&cus, hipDeviceAttributeMultiprocessorCount, dev);
        if (hipFuncSetAttribute((const void*)fwd_kernel, hipFuncAttributeMaxDynamicSharedMemorySize, LDS_BYTES) != hipSuccess) fprintf(stderr, "hipFuncSetAttribute failed\n");
        if (hipOccupancyMaxActiveBlocksPerMultiprocessor(&per_cu, (const void*)fwd_kernel, NT, LDS_BYTES) != hipSuccess || per_cu < 1) { fprintf(stderr, "occupancy query: %d\n", per_cu); per_cu = 1; }
        (void)hipGetLastError();
        grid_blocks = cus;
        if (ws_size < WS_NEED) fprintf(stderr, "workspace too small: %zu < %zu\n", ws_size, (size_t)WS_NEED);
    }
    Params p{};
    for (int i = 0; i < 23; ++i) p.in[i] = (const float*)d_in[i];
    p.out = (float*)d_out; p.ws = (unsigned char*)d_ws; p.ph_lo = 0; p.ph_hi = 14;
    (void)hipMemsetAsync((unsigned char*)d_ws + O_BAR, 0, BAR_BYTES, stream);
    void* args[] = {&p};
    hipError_t e = hipLaunchCooperativeKernel((const void*)fwd_kernel, dim3(grid_blocks), dim3(NT), args, LDS_BYTES, stream);
    if (e != hipSuccess) fprintf(stderr, "cooperative launch failed: %s (grid %d)\n", hipGetErrorString(e), grid_blocks);
}
```

```cpp
#include <hip/hip_runtime.h>
#include <hip/hip_cooperative_groups.h>
#include <cstdio>
namespace cg = cooperative_groups;

#define LAS __attribute__((address_space(3)))
typedef unsigned short bf16_t;
typedef short bf16x8 __attribute__((ext_vector_type(8)));
typedef float f32x4 __attribute__((ext_vector_type(4)));
typedef float f32x2 __attribute__((ext_vector_type(2)));
typedef unsigned u32x4 __attribute__((ext_vector_type(4)));
typedef unsigned u32x2 __attribute__((ext_vector_type(2)));

constexpr int D = 1024, MP_ROWS = 16384, MS_ROWS = 256, M = MP_ROWS + MS_ROWS, SEQ = 4096, DFF = 2816, PLE = 256;
constexpr int GIN = 3088, DK = 128, DV = 256, NH = 4, KEYD = 512;
constexpr int MPAD = M + 64;
constexpr int NITEM = 1024 + 64;
constexpr float EPS = 1e-6f;
constexpr int NT = 512;
constexpr int LDS_MAIN = 131072;
constexpr int LDS_BYTES = LDS_MAIN + 16;
#ifndef PHMASK
#define PHMASK 0xFFFF
#endif
#define EN(n) (((PHMASK) >> (n)) & 1)

constexpr size_t SZ_HB = (size_t)M * D * 2;
constexpr size_t O_WP = 0;
constexpr size_t O_WGU = O_WP + 4 * 256 * 256 * 2;
constexpr size_t O_WD = O_WGU + (size_t)2 * 5632 * 1024 * 2;
constexpr size_t O_WPG = O_WD + (size_t)2 * 1024 * 2816 * 2;
constexpr size_t O_WPP = O_WPG + (size_t)2 * 1024 * 1024 * 2;
constexpr size_t O_WIN = O_WPP + (size_t)2 * 1024 * 256 * 2;
constexpr size_t O_WGR = O_WIN + (size_t)3072 * 1024 * 2;
constexpr size_t O_WO = O_WGR + 16 * 1024 * 2;
constexpr size_t O_GR = O_WO + (size_t)1024 * 1024 * 2;
constexpr size_t O_SSQ = O_GR + (size_t)M * 16 * 4;
constexpr size_t O_DEC = O_SSQ + (size_t)7 * M * 4;
constexpr size_t O_BAR = O_DEC + (size_t)NITEM * 128 * 4;
constexpr size_t BAR_BYTES = 32768;
constexpr size_t O_HBA = O_BAR + BAR_BYTES;
constexpr size_t O_HBB = O_HBA + SZ_HB;
constexpr size_t O_BIG = O_HBB + SZ_HB;
constexpr size_t SZ_PB = (size_t)M * PLE * 2;
constexpr size_t O_PB1 = O_BIG;
constexpr size_t O_PP = O_BIG + SZ_PB;
constexpr size_t O_ACT = O_PP + SZ_HB;
constexpr size_t O_DM = O_ACT;
constexpr size_t O_PB0 = O_HBB;
constexpr size_t O_Q = O_HBB;
constexpr size_t O_K = O_HBB + (size_t)M * 512 * 2;
constexpr size_t O_OG = O_HBA;
constexpr size_t O_G = O_BIG + SZ_PB;
constexpr size_t O_VT = O_G + SZ_HB;
constexpr size_t O_KVT = O_VT + (size_t)1024 * MPAD * 2;
constexpr size_t WS_END_A = O_ACT + (size_t)M * DFF * 2;
constexpr size_t WS_END_B = O_KVT + (size_t)NITEM * 256 * 128 * 2;
constexpr size_t WS_NEED = WS_END_A > WS_END_B ? WS_END_A : WS_END_B;

constexpr size_t OUT_Y = 0;
constexpr size_t OUT_PSP = (size_t)M * D;
constexpr size_t OUT_PSS = OUT_PSP + 4 * 15 * 1024;
constexpr size_t OUT_GSP = OUT_PSS + 16 * 15 * 1024;
constexpr size_t OUT_GSS = OUT_GSP + (size_t)16 * 128 * 256;

struct Params {
    const float* in[23];
    float* out;
    unsigned char* ws;
    int ph_lo, ph_hi;
};

__device__ __forceinline__ unsigned cvt_pk_bf16(float lo, float hi) { unsigned r; asm volatile("v_cvt_pk_bf16_f32 %0, %1, %2" : "=v"(r) : "v"(lo), "v"(hi)); return r; }
__device__ __forceinline__ float bf_lo(unsigned w) { return __uint_as_float(w << 16); }
__device__ __forceinline__ float bf_hi(unsigned w) { return __uint_as_float(w & 0xffff0000u); }
__device__ __forceinline__ float bf1(bf16_t b) { return __uint_as_float(((unsigned)b) << 16); }
__device__ __forceinline__ float sigmoidf_(float x) { return __builtin_amdgcn_rcpf(1.0f + __expf(-x)); }
__device__ __forceinline__ float siluf_(float x) { return x * sigmoidf_(x); }
__device__ __forceinline__ float rinv_of(float ssq) { return rsqrtf(ssq * (1.0f / 1024.0f) + EPS); }


#define XB_TMO      128
#define XB_XCNT(j)  (256  + 64 * (j))
#define XB_XSUB(j)  (1280 + 64 * (j))
#define XB_XGEN(j)  (2304 + 64 * (j))
#define XB_TOP      3328
#define XB_TOPGEN   3392
#define XB_SPIN_CAP (1u << 18)
__device__ __forceinline__ unsigned xb_ld(unsigned* p)              { return __hip_atomic_load(p, __ATOMIC_RELAXED, __HIP_MEMORY_SCOPE_AGENT); }
__device__ __forceinline__ unsigned xb_add(unsigned* p, unsigned v) { return __hip_atomic_fetch_add(p, v, __ATOMIC_RELAXED, __HIP_MEMORY_SCOPE_AGENT); }
__device__ __forceinline__ unsigned xb_xcc_id() { return (unsigned)__builtin_amdgcn_s_getreg((3 << 11) | 20) & 0xFu; }
#define XB_SPIN(cond, bar) do { unsigned _sp = 0; while (cond) { __builtin_amdgcn_s_sleep(1); \
    if ((++_sp & 255u) == 0u) { if (xb_ld(&(bar)[XB_TMO])) break; if (_sp > XB_SPIN_CAP) { atomicAdd(&(bar)[XB_TMO], 1u); break; } } } } while (0)
struct XcdBarrier { unsigned* bar; unsigned x; volatile LAS unsigned* st; };
__device__ __forceinline__ XcdBarrier xcd_barrier_post(unsigned* bar, volatile LAS unsigned* st) {
    XcdBarrier b; b.bar = bar; b.x = xb_xcc_id(); b.st = st;
    if (threadIdx.x == 0) (void)xb_add(&bar[XB_XCNT(b.x)], 1u);
    return b;
}
__device__ __forceinline__ void xcd_barrier_complete(unsigned* bar, unsigned x, unsigned& nloc, unsigned& nx) {
    const unsigned G = gridDim.x * gridDim.y * gridDim.z;
    unsigned sum, cnt, mine, sp = 0u;
    for (;;) {
        sum = 0u; cnt = 0u; mine = 0u;
#pragma unroll
        for (unsigned j = 0; j < 16; ++j) { const unsigned c = xb_ld(&bar[XB_XCNT(j)]); sum += c; cnt += (c > 0u) ? 1u : 0u; mine = (j == x) ? c : mine; }
        if (sum == G) break;
        __builtin_amdgcn_s_sleep(1);
        if ((++sp & 255u) == 0u) { if (xb_ld(&bar[XB_TMO])) break; if (sp > XB_SPIN_CAP) { atomicAdd(&bar[XB_TMO], 1u); break; } }
    }
    nloc = mine > 0u ? mine : 1u; nx = cnt > 0u ? cnt : 1u;
}
__device__ __forceinline__ void xcd_barrier(const XcdBarrier& b) {
    asm volatile("s_waitcnt vmcnt(0)" ::: "memory");
    __syncthreads();
    if (threadIdx.x == 0) {
        unsigned* bar = b.bar;
        __builtin_amdgcn_s_waitcnt(0);
        unsigned nloc = b.st[0], nx = b.st[1];
        if (nloc == 0u) { xcd_barrier_complete(bar, b.x, nloc, nx); b.st[0] = nloc; b.st[1] = nx; }
        const unsigned old = xb_add(&bar[XB_XSUB(b.x)], 1u);
        const unsigned gen = old / nloc;
        if (old + 1u == (gen + 1u) * nloc) {
            __builtin_amdgcn_fence(__ATOMIC_RELEASE, "agent");
            asm volatile("s_waitcnt vmcnt(0)" ::: "memory");
            const unsigned og = xb_add(&bar[XB_TOP], 1u);
            const unsigned tg = og / nx;
            if (og + 1u == (tg + 1u) * nx) xb_add(&bar[XB_TOPGEN], 1u);
            else XB_SPIN(xb_ld(&bar[XB_TOPGEN]) == tg, bar);
            __builtin_amdgcn_fence(__ATOMIC_ACQUIRE, "agent");
            xb_add(&bar[XB_XGEN(b.x)], 1u);
            asm volatile("s_waitcnt vmcnt(0)" ::: "memory");
        } else {
            XB_SPIN(xb_ld(&bar[XB_XGEN(b.x)]) == gen, bar);
            __builtin_amdgcn_fence(__ATOMIC_ACQUIRE, "agent");
            asm volatile("s_waitcnt vmcnt(0)" ::: "memory");
        }
    }
    __syncthreads();
}

namespace pg8 {
constexpr int BM = 256, BK = 64, HALF = 128, HTB = HALF * BK * 2, NXCD = 8, WGM = 4;
__device__ __forceinline__ int lds_byte(int r, int c) { const int st = (r >> 4) * 2 + (c >> 5), rr = r & 15, cc = c & 31, ob = rr * 64 + cc * 2; return st * 1024 + (ob ^ (((ob >> 9) & 1) << 5)); }
__device__ __forceinline__ void stage_rc(int b, int& R, int& C) { const int st = b / 1024, sb = b % 1024, swz = sb ^ (((sb >> 9) & 1) << 5); R = (st >> 1) * 16 + swz / 64; C = (st & 1) * 32 + (swz % 64) / 2; }
__device__ __forceinline__ int perm32(int rho) { const int n = rho >> 4, i = rho & 15; return 8 * (i >> 2) + 4 * n + (i & 3); }
struct Unit { int pm, pn; };
struct Gemm { const bf16_t* A; const bf16_t* Bt; int lda, ldb, K, a_pn_off; };
struct StaticOrder {
    int nM, nN, nwg, G, c;
    __device__ __forceinline__ void init(int nM_, int nN_, int G_, int c_) { nM = nM_; nN = nN_; nwg = nM * nN; G = G_; c = c_; }
    __device__ __forceinline__ bool next(int i, Unit& u) const {
        const long L = (long)i * G + c; if (L >= nwg) return false;
        int wgid = (int)L; { const int q = nwg / NXCD, r = nwg % NXCD, xcd = wgid % NXCD, off = wgid / NXCD; wgid = (xcd < r ? xcd * (q + 1) : r * (q + 1) + (xcd - r) * q) + off; }
        const int nig = WGM * nN, gid = wgid / nig, fm = gid * WGM, gsz = (nM - fm) < WGM ? (nM - fm) : WGM;
        u.pm = fm + ((wgid % nig) % gsz); u.pn = (wgid % nig) / gsz; return true;
    }
};

template <class Epi>
__device__ __forceinline__ void gemm_phase(LAS unsigned char* lds, const Gemm g, const StaticOrder& S, const Epi& E) {
    int tid = threadIdx.x; asm volatile("" : "+v"(tid));
    const int wid = __builtin_amdgcn_readfirstlane(tid >> 6), lane = tid & 63, wr = wid >> 2, wc = wid & 3, fr = lane & 15, fq = lane >> 4;
    int K = g.K; asm volatile("" : "+s"(K));
    const int nt = K / BK;
    unsigned voffA[2], voffB[2];
#pragma unroll
    for (int i = 0; i < 2; ++i) { int R, C; stage_rc(tid * 16 + i * 8192, R, C); const int Rb = (R & ~31) + perm32(R & 31);
        voffA[i] = (unsigned)(R * g.lda + C) * 2u; voffB[i] = (unsigned)(Rb * g.ldb + C) * 2u; }
    const size_t kstep = (size_t)(BK * 2);
    const size_t hstepA = (size_t)HALF * g.lda * 2, hstepB = (size_t)HALF * g.ldb * 2;
    const size_t tstepA = 2 * hstepA, tstepB = 2 * hstepB;
    const unsigned ldsw = (unsigned)wid * 1024u;
    const int aoff = lds_byte(wr * 64 + fr, fq * 8), boff = lds_byte(wc * 32 + fr, fq * 8);
#define PG8_SA(b, h) (((b) * 2 + (h)) * HTB)
#define PG8_SB(b, h) ((4 + (b) * 2 + (h)) * HTB)
#define PG8_STAGE(bufoff, gbase, voff) do { _Pragma("unroll") for (int _i = 0; _i < 2; ++_i) \
        __builtin_amdgcn_global_load_lds((const unsigned*)((const char*)(gbase) + (voff)[_i]), (LAS unsigned*)(lds + (bufoff) + ldsw + _i * 8192), 16, 0, 0); } while (0)
#define PG8_LDA(dst, b, h) do { _Pragma("unroll") for (int m = 0; m < 4; ++m) _Pragma("unroll") for (int k = 0; k < 2; ++k) dst[m][k] = *(const LAS bf16x8*)(lds + PG8_SA(b, h) + aoff + m * 2048 + k * 1024); } while (0)
#define PG8_LDB(dst, b, h) do { _Pragma("unroll") for (int n = 0; n < 2; ++n) _Pragma("unroll") for (int k = 0; k < 2; ++k) dst[n][k] = *(const LAS bf16x8*)(lds + PG8_SB(b, h) + boff + n * 2048 + k * 1024); } while (0)
#define PG8_MMA(ai, bj, At, Bt) do { __builtin_amdgcn_s_setprio(1); _Pragma("unroll") for (int m = 0; m < 4; ++m) _Pragma("unroll") for (int n = 0; n < 2; ++n) _Pragma("unroll") for (int k = 0; k < 2; ++k) \
        acc[ai][bj][m][n] = __builtin_amdgcn_mfma_f32_16x16x32_bf16(Bt[n][k], At[m][k], acc[ai][bj][m][n], 0, 0, 0); __builtin_amdgcn_s_setprio(0); } while (0)
#define PG8_WAIT_V(n) asm volatile("s_waitcnt vmcnt(" #n ")" ::: "memory")
#define PG8_WAIT_L(n) asm volatile("s_waitcnt lgkmcnt(" #n ")" ::: "memory")
#define PG8_BAR __builtin_amdgcn_s_barrier()
#define PG8_SCHED __builtin_amdgcn_sched_barrier(0)
    Unit cur, nxt; int ui = 0;
    if (!S.next(0, cur)) return;
    f32x4 acc[2][2][4][2];
#pragma unroll
    for (int a = 0; a < 2; ++a)
#pragma unroll
        for (int b = 0; b < 2; ++b)
#pragma unroll
            for (int m = 0; m < 4; ++m)
#pragma unroll
                for (int n = 0; n < 2; ++n) acc[a][b][m][n] = (f32x4){0.f, 0.f, 0.f, 0.f};
    bf16x8 At[4][2], B0[2][2], B1[2][2];
    const char* cA = (const char*)g.A + (size_t)cur.pm * tstepA + (size_t)cur.pn * g.a_pn_off * 2; const char* cB = (const char*)g.Bt + (size_t)cur.pn * tstepB;
    PG8_STAGE(PG8_SB(0, 0), cB, voffB); PG8_STAGE(PG8_SA(0, 0), cA, voffA); PG8_STAGE(PG8_SB(0, 1), cB + hstepB, voffB); PG8_STAGE(PG8_SA(0, 1), cA + hstepA, voffA);
    if (wr == 1) PG8_BAR;
    PG8_WAIT_V(4); PG8_BAR;
    PG8_STAGE(PG8_SB(1, 0), cB + kstep, voffB); PG8_STAGE(PG8_SA(1, 0), cA + kstep, voffA); PG8_STAGE(PG8_SB(1, 1), cB + hstepB + kstep, voffB);
    PG8_WAIT_V(6); PG8_BAR;
    for (;;) {
        const bool has_next = S.next(ui + 1, nxt);
        const char* nA = has_next ? (const char*)g.A + (size_t)nxt.pm * tstepA + (size_t)nxt.pn * g.a_pn_off * 2 : cA; const char* nB = has_next ? (const char*)g.Bt + (size_t)nxt.pn * tstepB : cB;
        for (int t = 0; t < nt; t += 2) {
            const bool last = (t == nt - 2);
            const char* a1 = cA + (size_t)(t + 1) * kstep;
            const char* a2 = last ? nA : cA + (size_t)(t + 2) * kstep; const char* b2 = last ? nB : cB + (size_t)(t + 2) * kstep;
            const char* a3 = a2 + kstep; const char* b3 = b2 + kstep;
            PG8_LDB(B0, 0, 0); PG8_SCHED; PG8_LDA(At, 0, 0); PG8_STAGE(PG8_SA(1, 1), a1 + hstepA, voffA);
            PG8_WAIT_L(8); PG8_BAR; PG8_WAIT_L(0); PG8_MMA(0, 0, At, B0); PG8_BAR; PG8_SCHED;
            PG8_LDB(B1, 0, 1); PG8_STAGE(PG8_SB(0, 0), b2, voffB);
            PG8_BAR; PG8_WAIT_L(0); PG8_MMA(0, 1, At, B1); PG8_BAR;
            PG8_LDA(At, 0, 1); PG8_STAGE(PG8_SA(0, 0), a2, voffA);
            PG8_BAR; PG8_WAIT_L(0); PG8_MMA(1, 0, At, B0); PG8_BAR; PG8_SCHED;
            PG8_STAGE(PG8_SB(0, 1), b2 + hstepB, voffB);
            PG8_WAIT_V(6); PG8_BAR; PG8_MMA(1, 1, At, B1); PG8_BAR;
            PG8_LDB(B0, 1, 0); PG8_SCHED; PG8_LDA(At, 1, 0); PG8_STAGE(PG8_SA(0, 1), a2 + hstepA, voffA);
            PG8_WAIT_L(8); PG8_BAR; PG8_WAIT_L(0); PG8_MMA(0, 0, At, B0); PG8_BAR; PG8_SCHED;
            PG8_LDB(B1, 1, 1); PG8_STAGE(PG8_SB(1, 0), b3, voffB);
            PG8_BAR; PG8_WAIT_L(0); PG8_MMA(0, 1, At, B1); PG8_BAR;
            PG8_LDA(At, 1, 1); PG8_STAGE(PG8_SA(1, 0), a3, voffA);
            PG8_BAR; PG8_WAIT_L(0); PG8_MMA(1, 0, At, B0); PG8_BAR; PG8_SCHED;
            PG8_STAGE(PG8_SB(1, 1), b3 + hstepB, voffB);
            PG8_WAIT_V(6); PG8_BAR; PG8_MMA(1, 1, At, B1); PG8_BAR;
        }
        E(acc, cur, wr, wc, fr, fq);
        if (!has_next) break;
#pragma unroll
        for (int a = 0; a < 2; ++a)
#pragma unroll
            for (int b = 0; b < 2; ++b)
#pragma unroll
                for (int m = 0; m < 4; ++m)
#pragma unroll
                    for (int n = 0; n < 2; ++n) acc[a][b][m][n] = (f32x4){0.f, 0.f, 0.f, 0.f};
        cur = nxt; cA = nA; cB = nB; ++ui;
    }
    PG8_WAIT_V(0);
    if (wr == 0) PG8_BAR;
    PG8_BAR;
#undef PG8_SA
#undef PG8_SB
#undef PG8_STAGE
#undef PG8_LDA
#undef PG8_LDB
#undef PG8_MMA
#undef PG8_WAIT_V
#undef PG8_WAIT_L
#undef PG8_BAR
#undef PG8_SCHED
}
}

typedef f32x4 AccT[2][2][4][2];
#define EPI_ROW(u, ai, m) ((u).pm * 256 + (ai) * 128 + wr * 64 + (m) * 16 + fr)
#define EPI_COL(u, bj) ((u).pn * 256 + (bj) * 128 + wc * 32 + 8 * fq)

__device__ __forceinline__ u32x4 pack8(const f32x4 a, const f32x4 b) { u32x4 w; w.x = cvt_pk_bf16(a[0], a[1]); w.y = cvt_pk_bf16(a[2], a[3]); w.z = cvt_pk_bf16(b[0], b[1]); w.w = cvt_pk_bf16(b[2], b[3]); return w; }
__device__ __forceinline__ float sq8(const f32x4 a, const f32x4 b) { return (a[0] * a[0] + a[1] * a[1]) + (a[2] * a[2] + a[3] * a[3]) + (b[0] * b[0] + b[1] * b[1]) + (b[2] * b[2] + b[3] * b[3]); }
__device__ __forceinline__ void ssq_commit(float s, float* ssq, int r, int fq) { s += __shfl_xor(s, 16); s += __shfl_xor(s, 32); if (fq == 0) atomicAdd(ssq + r, s); }

struct EpiPool {
    const float* xp; const float* xs; float* h; bf16_t* hb; const float* bias; const float* scale; float* ssq;
    static constexpr bool HAS_SSQ = true;
    __device__ __forceinline__ float apply8(int r, int c, const f32x4 a0, const f32x4 a1) const {
        const float* xrow = r < MP_ROWS ? xp + (size_t)r * D : xs + (size_t)(r - MP_ROWS) * D;
        const f32x4 v0 = *(const f32x4*)(xrow + c) + (a0 + *(const f32x4*)(bias + c)) * *(const f32x4*)(scale + c);
        const f32x4 v1 = *(const f32x4*)(xrow + c + 4) + (a1 + *(const f32x4*)(bias + c + 4)) * *(const f32x4*)(scale + c + 4);
        *(f32x4*)(h + (size_t)r * D + c) = v0; *(f32x4*)(h + (size_t)r * D + c + 4) = v1; *(u32x4*)(hb + (size_t)r * D + c) = pack8(v0, v1); return sq8(v0, v1); }
    __device__ __forceinline__ void operator()(const AccT& acc, const pg8::Unit& u, int wr, int wc, int fr, int fq) const {
        asm volatile("" : "+v"(fr), "+v"(fq), "+s"(wr), "+s"(wc));
#pragma unroll
        for (int ai = 0; ai < 2; ++ai)
#pragma unroll
            for (int mp = 0; mp < 2; ++mp) {
                f32x4 xv[2][2][2], bb[2][2], sc[2][2];
#pragma unroll
                for (int bj = 0; bj < 2; ++bj) { const int c = EPI_COL(u, bj); bb[bj][0] = *(const f32x4*)(bias + c); bb[bj][1] = *(const f32x4*)(bias + c + 4); sc[bj][0] = *(const f32x4*)(scale + c); sc[bj][1] = *(const f32x4*)(scale + c + 4); }
#pragma unroll
                for (int mm = 0; mm < 2; ++mm) { const int r = EPI_ROW(u, ai, 2 * mp + mm); const float* xrow = r < MP_ROWS ? xp + (size_t)r * D : xs + (size_t)(r - MP_ROWS) * D;
#pragma unroll
                    for (int bj = 0; bj < 2; ++bj) { const int c = EPI_COL(u, bj); xv[mm][bj][0] = *(const f32x4*)(xrow + c); xv[mm][bj][1] = *(const f32x4*)(xrow + c + 4); } }
#pragma unroll
                for (int mm = 0; mm < 2; ++mm) { const int m = 2 * mp + mm, r = EPI_ROW(u, ai, m); float s = 0.f;
#pragma unroll
                    for (int bj = 0; bj < 2; ++bj) { const int c = EPI_COL(u, bj);
                        const f32x4 v0 = xv[mm][bj][0] + (acc[ai][bj][m][0] + bb[bj][0]) * sc[bj][0], v1 = xv[mm][bj][1] + (acc[ai][bj][m][1] + bb[bj][1]) * sc[bj][1];
                        *(f32x4*)(h + (size_t)r * D + c) = v0; *(f32x4*)(h + (size_t)r * D + c + 4) = v1;
                        *(u32x4*)(hb + (size_t)r * D + c) = pack8(v0, v1); s += sq8(v0, v1); }
                    ssq_commit(s, ssq, r, fq); }
                asm volatile("" ::: "memory"); }
    }
};
struct EpiRes {
    float* h; bf16_t* hb; float* ssq; float mul;
    static constexpr bool HAS_SSQ = true;
    __device__ __forceinline__ float apply8(int r, int c, const f32x4 a0, const f32x4 a1) const {
        float* hp = h + (size_t)r * D + c; const f32x4 v0 = *(const f32x4*)hp + a0 * mul, v1 = *(const f32x4*)(hp + 4) + a1 * mul;
        *(f32x4*)hp = v0; *(f32x4*)(hp + 4) = v1; *(u32x4*)(hb + (size_t)r * D + c) = pack8(v0, v1); return sq8(v0, v1); }
    __device__ __forceinline__ void operator()(const AccT& acc, const pg8::Unit& u, int wr, int wc, int fr, int fq) const {
        asm volatile("" : "+v"(fr), "+v"(fq), "+s"(wr), "+s"(wc));
#pragma unroll
        for (int ai = 0; ai < 2; ++ai) {
            f32x4 hv[4][2][2];
#pragma unroll
            for (int m = 0; m < 4; ++m)
#pragma unroll
                for (int bj = 0; bj < 2; ++bj) { const float* hp = h + (size_t)EPI_ROW(u, ai, m) * D + EPI_COL(u, bj); hv[m][bj][0] = *(const f32x4*)hp; hv[m][bj][1] = *(const f32x4*)(hp + 4); }
#pragma unroll
            for (int m = 0; m < 4; ++m) {
                const int r = EPI_ROW(u, ai, m); float s = 0.f;
#pragma unroll
                for (int bj = 0; bj < 2; ++bj) { const int c = EPI_COL(u, bj); float* hp = h + (size_t)r * D + c;
                    const f32x4 v0 = hv[m][bj][0] + acc[ai][bj][m][0] * mul, v1 = hv[m][bj][1] + acc[ai][bj][m][1] * mul;
                    *(f32x4*)hp = v0; *(f32x4*)(hp + 4) = v1;
                    *(u32x4*)(hb + (size_t)r * D + c) = pack8(v0, v1); s += sq8(v0, v1); }
                ssq_commit(s, ssq, r, fq); }
            asm volatile("" ::: "memory"); }
    }
};
struct EpiPle {
    float* h; bf16_t* hb; const bf16_t* pp; const float* ssq_in; float* ssq; float mul;
    static constexpr bool HAS_SSQ = true;
    __device__ __forceinline__ float apply8(int r, int c, const f32x4 a0_, const f32x4 a1_) const {
        const float ri = rinv_of(ssq_in[r]); float* hp = h + (size_t)r * D + c; const u32x4 pw = *(const u32x4*)(pp + (size_t)r * D + c);
        const f32x4 a0 = a0_ * ri, a1 = a1_ * ri; f32x4 v0 = *(const f32x4*)hp, v1 = *(const f32x4*)(hp + 4);
        if (mul == 0.f) { *(u32x4*)(hb + (size_t)r * D + c) = pack8(v0, v1); return 0.f; }
        v0[0] += sigmoidf_(a0[0]) * bf_lo(pw.x); v0[1] += sigmoidf_(a0[1]) * bf_hi(pw.x); v0[2] += sigmoidf_(a0[2]) * bf_lo(pw.y); v0[3] += sigmoidf_(a0[3]) * bf_hi(pw.y);
        v1[0] += sigmoidf_(a1[0]) * bf_lo(pw.z); v1[1] += sigmoidf_(a1[1]) * bf_hi(pw.z); v1[2] += sigmoidf_(a1[2]) * bf_lo(pw.w); v1[3] += sigmoidf_(a1[3]) * bf_hi(pw.w);
        *(f32x4*)hp = v0; *(f32x4*)(hp + 4) = v1; *(u32x4*)(hb + (size_t)r * D + c) = pack8(v0, v1); return sq8(v0, v1); }
    __device__ __forceinline__ void operator()(const AccT& acc, const pg8::Unit& u, int wr, int wc, int fr, int fq) const {
        asm volatile("" : "+v"(fr), "+v"(fq), "+s"(wr), "+s"(wc));
#pragma unroll
        for (int ai = 0; ai < 2; ++ai)
#pragma unroll
            for (int mp = 0; mp < 2; ++mp) {
                f32x4 hv[2][2][2]; u32x4 pw[2][2]; float rs[2];
#pragma unroll
                for (int mm = 0; mm < 2; ++mm) { const int r = EPI_ROW(u, ai, 2 * mp + mm); rs[mm] = ssq_in[r];
#pragma unroll
                    for (int bj = 0; bj < 2; ++bj) { const int c = EPI_COL(u, bj); const float* hp = h + (size_t)r * D + c; hv[mm][bj][0] = *(const f32x4*)hp; hv[mm][bj][1] = *(const f32x4*)(hp + 4); pw[mm][bj] = *(const u32x4*)(pp + (size_t)r * D + c); } }
#pragma unroll
                for (int mm = 0; mm < 2; ++mm) { const int m = 2 * mp + mm, r = EPI_ROW(u, ai, m); float s = 0.f; const float ri = rinv_of(rs[mm]);
#pragma unroll
                    for (int bj = 0; bj < 2; ++bj) { const int c = EPI_COL(u, bj); float* hp = h + (size_t)r * D + c; const u32x4 p4 = pw[mm][bj];
                        const f32x4 a0 = acc[ai][bj][m][0] * ri, a1 = acc[ai][bj][m][1] * ri; f32x4 v0 = hv[mm][bj][0], v1 = hv[mm][bj][1];
                        v0[0] += mul * sigmoidf_(a0[0]) * bf_lo(p4.x); v0[1] += mul * sigmoidf_(a0[1]) * bf_hi(p4.x); v0[2] += mul * sigmoidf_(a0[2]) * bf_lo(p4.y); v0[3] += mul * sigmoidf_(a0[3]) * bf_hi(p4.y);
                        v1[0] += mul * sigmoidf_(a1[0]) * bf_lo(p4.z); v1[1] += mul * sigmoidf_(a1[1]) * bf_hi(p4.z); v1[2] += mul * sigmoidf_(a1[2]) * bf_lo(p4.w); v1[3] += mul * sigmoidf_(a1[3]) * bf_hi(p4.w);
                        *(f32x4*)hp = v0; *(f32x4*)(hp + 4) = v1;
                        *(u32x4*)(hb + (size_t)r * D + c) = pack8(v0, v1); s += sq8(v0, v1); }
                    ssq_commit(s, ssq, r, fq); }
                asm volatile("" ::: "memory"); }
    }
};
struct EpiGU {
    bf16_t* act; const float* ssq_in;
    __device__ __forceinline__ void operator()(const AccT& acc, const pg8::Unit& u, int wr, int wc, int fr, int fq) const {
        asm volatile("" : "+v"(fr), "+v"(fq), "+s"(wr), "+s"(wc));
        float ris[2][4];
#pragma unroll
        for (int ai = 0; ai < 2; ++ai)
#pragma unroll
            for (int m = 0; m < 4; ++m) ris[ai][m] = ssq_in[EPI_ROW(u, ai, m)];
#pragma unroll
        for (int ai = 0; ai < 2; ++ai)
#pragma unroll
            for (int m = 0; m < 4; ++m) {
                const int r = EPI_ROW(u, ai, m); const float ri = rinv_of(ris[ai][m]);
                f32x4 o[2];
#pragma unroll
                for (int n = 0; n < 2; ++n) { const f32x4 gt = acc[ai][0][m][n] * ri, up = acc[ai][1][m][n] * ri;
#pragma unroll
                    for (int j = 0; j < 4; ++j) o[n][j] = siluf_(gt[j]) * up[j]; }
                *(u32x4*)(act + (size_t)r * DFF + u.pn * 128 + wc * 32 + 8 * fq) = pack8(o[0], o[1]); }
    }
};
struct EpiBf {
    bf16_t* O; int ldc;
    static constexpr bool HAS_SSQ = false; float* ssq;
    __device__ __forceinline__ float apply8(int r, int c, const f32x4 a0, const f32x4 a1) const { *(u32x4*)(O + (size_t)r * ldc + c) = pack8(a0, a1); return 0.f; }
    __device__ __forceinline__ void operator()(const AccT& acc, const pg8::Unit& u, int wr, int wc, int fr, int fq) const {
        asm volatile("" : "+v"(fr), "+v"(fq), "+s"(wr), "+s"(wc));
#pragma unroll
        for (int ai = 0; ai < 2; ++ai)
#pragma unroll
            for (int m = 0; m < 4; ++m) { const int r = EPI_ROW(u, ai, m);
#pragma unroll
                for (int bj = 0; bj < 2; ++bj) { const int c = EPI_COL(u, bj); *(u32x4*)(O + (size_t)r * ldc + c) = pack8(acc[ai][bj][m][0], acc[ai][bj][m][1]); } }
    }
};
struct EpiQKG {
    bf16_t* q; bf16_t* k; bf16_t* g; const float* ssq_in;
    static constexpr bool HAS_SSQ = false; float* ssq;
    __device__ __forceinline__ float apply8(int r, int c, const f32x4 a0, const f32x4 a1) const {
        bf16_t* base; int ldc, cc; float sc = 1.0f;
        if (c < 512) { base = q; ldc = KEYD; cc = c; sc = 0.08838834764831845f; } else if (c < 1024) { base = k; ldc = KEYD; cc = c - 512; } else { base = g; ldc = D; cc = c - 1024; }
        const float ri = rinv_of(ssq_in[r]) * sc; *(u32x4*)(base + (size_t)r * ldc + cc) = pack8(a0 * ri, a1 * ri); return 0.f; }
    __device__ __forceinline__ void operator()(const AccT& acc, const pg8::Unit& u, int wr, int wc, int fr, int fq) const {
        asm volatile("" : "+v"(fr), "+v"(fq), "+s"(wr), "+s"(wc));
        bf16_t* base; int ldc, ct; float sc = 1.0f;
        if (u.pn < 2) { base = q; ldc = KEYD; ct = u.pn; sc = 0.08838834764831845f; } else if (u.pn < 4) { base = k; ldc = KEYD; ct = u.pn - 2; } else { base = g; ldc = D; ct = u.pn - 4; }
        float ris[2][4];
#pragma unroll
        for (int ai = 0; ai < 2; ++ai)
#pragma unroll
            for (int m = 0; m < 4; ++m) ris[ai][m] = ssq_in[EPI_ROW(u, ai, m)];
#pragma unroll
        for (int ai = 0; ai < 2; ++ai)
#pragma unroll
            for (int m = 0; m < 4; ++m) { const int r = EPI_ROW(u, ai, m); const float ri = rinv_of(ris[ai][m]) * sc;
#pragma unroll
                for (int bj = 0; bj < 2; ++bj) { const int c = ct * 256 + bj * 128 + wc * 32 + 8 * fq;
                    *(u32x4*)(base + (size_t)r * ldc + c) = pack8(acc[ai][bj][m][0] * ri, acc[ai][bj][m][1] * ri); } }
    }
};
struct EpiVT {
    bf16_t* vT; const float* ssq_in;
    static constexpr bool HAS_SSQ = false; float* ssq;
    __device__ __forceinline__ float apply8(int r, int c, const f32x4 a0, const f32x4 a1) const {
        const float ri = rinv_of(ssq_in[r]); const u32x4 w = pack8(a0 * ri, a1 * ri); bf16_t* p = vT + (size_t)c * MPAD + r;
        p[0] = (bf16_t)(w.x & 0xffffu); p[MPAD] = (bf16_t)(w.x >> 16); p[2 * (size_t)MPAD] = (bf16_t)(w.y & 0xffffu); p[3 * (size_t)MPAD] = (bf16_t)(w.y >> 16);
        p[4 * (size_t)MPAD] = (bf16_t)(w.z & 0xffffu); p[5 * (size_t)MPAD] = (bf16_t)(w.z >> 16); p[6 * (size_t)MPAD] = (bf16_t)(w.w & 0xffffu); p[7 * (size_t)MPAD] = (bf16_t)(w.w >> 16); return 0.f; }
    __device__ __forceinline__ void operator()(const AccT& acc, const pg8::Unit& u, int wr, int wc, int fr, int fq) const {
        asm volatile("" : "+v"(fr), "+v"(fq), "+s"(wr), "+s"(wc));
        f32x4 rs[2][2];
#pragma unroll
        for (int bj = 0; bj < 2; ++bj) { const int c = EPI_COL(u, bj); const f32x4 s0 = *(const f32x4*)(ssq_in + c), s1 = *(const f32x4*)(ssq_in + c + 4);
#pragma unroll
            for (int j = 0; j < 4; ++j) { rs[bj][0][j] = rinv_of(s0[j]); rs[bj][1][j] = rinv_of(s1[j]); } }
#pragma unroll
        for (int ai = 0; ai < 2; ++ai)
#pragma unroll
            for (int m = 0; m < 4; ++m) { const int r = EPI_ROW(u, ai, m);
#pragma unroll
                for (int bj = 0; bj < 2; ++bj) { const int c = EPI_COL(u, bj);
                    *(u32x4*)(vT + (size_t)r * MPAD + c) = pack8(acc[ai][bj][m][0] * rs[bj][0], acc[ai][bj][m][1] * rs[bj][1]); } }
    }
};


template <class Epi>
__device__ __forceinline__ void small_gemm(unsigned char* lds, const bf16_t* A, int lda, const bf16_t* Bt, int ldb, int K, int ncol_tiles, int a_grp_off, const Epi& E, int first = -1, int stride = 0) {
    int tid = threadIdx.x; asm volatile("" : "+v"(tid));
    const int wid = tid >> 6, lane = tid & 63, fr = lane & 15, fq = lane >> 4;
    float* part = (float*)lds;
    const int kw = K >> 3, ksteps = kw >> 5;
    if (first < 0) { first = blockIdx.x; stride = gridDim.x; }
    for (int tile = first; tile < 8 * ncol_tiles; tile += stride) {
        const int rt = tile & 7, ct = tile >> 3, r0 = MP_ROWS + 32 * rt, c0 = 32 * ct;
        const bf16_t* ap = A + (size_t)(r0 + fr) * lda + (c0 >> 8) * a_grp_off + wid * kw + 8 * fq;
        const bf16_t* bp = Bt + (size_t)(c0 + fr) * ldb + wid * kw + 8 * fq;
        f32x4 acc[2][2];
#pragma unroll
        for (int i = 0; i < 2; ++i)
#pragma unroll
            for (int j = 0; j < 2; ++j) acc[i][j] = (f32x4){0.f, 0.f, 0.f, 0.f};
        for (int s0 = 0; s0 < ksteps; s0 += 4) {
            bf16x8 a0[4], a1[4], b0[4], b1[4];
#pragma unroll
            for (int j = 0; j < 4; ++j) if (s0 + j < ksteps) { const int s = s0 + j;
                a0[j] = *(const bf16x8*)(ap + 32 * s); a1[j] = *(const bf16x8*)(ap + (size_t)16 * lda + 32 * s);
                b0[j] = *(const bf16x8*)(bp + 32 * s); b1[j] = *(const bf16x8*)(bp + (size_t)16 * ldb + 32 * s); }
#pragma unroll
            for (int j = 0; j < 4; ++j) if (s0 + j < ksteps) {
                acc[0][0] = __builtin_amdgcn_mfma_f32_16x16x32_bf16(b0[j], a0[j], acc[0][0], 0, 0, 0); acc[0][1] = __builtin_amdgcn_mfma_f32_16x16x32_bf16(b1[j], a0[j], acc[0][1], 0, 0, 0);
                acc[1][0] = __builtin_amdgcn_mfma_f32_16x16x32_bf16(b0[j], a1[j], acc[1][0], 0, 0, 0); acc[1][1] = __builtin_amdgcn_mfma_f32_16x16x32_bf16(b1[j], a1[j], acc[1][1], 0, 0, 0); } }
#pragma unroll
        for (int i = 0; i < 2; ++i)
#pragma unroll
            for (int j = 0; j < 2; ++j) *(f32x4*)(part + (wid * 32 + 16 * i + fr) * 36 + 16 * j + 4 * fq) = acc[i][j];
        __syncthreads();
        if (tid < 128) { const int row = tid >> 2, oct = tid & 3; f32x4 v0 = (f32x4){0.f, 0.f, 0.f, 0.f}, v1 = v0;
#pragma unroll
            for (int w = 0; w < 8; ++w) { v0 += *(const f32x4*)(part + (w * 32 + row) * 36 + 8 * oct); v1 += *(const f32x4*)(part + (w * 32 + row) * 36 + 8 * oct + 4); }
            float sq = E.apply8(r0 + row, c0 + 8 * oct, v0, v1);
            if (Epi::HAS_SSQ) { sq += __shfl_xor(sq, 1); sq += __shfl_xor(sq, 2); if (oct == 0) atomicAdd(E.ssq + r0 + row, sq); } }
        __syncthreads();
    }
}

__device__ __forceinline__ void transpose_tile(const float* src, int ldsrc, int k0, int n0, bf16_t* dst, int ldd, const float* gain, int rowmode, float* T) {
    const int tid = threadIdx.x;
    { const int kk = tid >> 4, n4 = (tid & 15) * 4; const float* gp = gain ? gain : src;
        const f32x4 v0 = *(const f32x4*)(src + (size_t)(k0 + kk) * ldsrc + n0 + n4), v1 = *(const f32x4*)(src + (size_t)(k0 + kk + 32) * ldsrc + n0 + n4);
        float g0 = gp[k0 + kk], g1 = gp[k0 + kk + 32]; if (!gain) { g0 = 1.0f; g1 = 1.0f; }
#pragma unroll
        for (int j = 0; j < 4; ++j) { T[(n4 + j) * 65 + kk] = v0[j] * g0; T[(n4 + j) * 65 + kk + 32] = v1[j] * g1; } }
    __syncthreads();
    { const int n = tid >> 3, k8 = (tid & 7) * 8; const float* tp = T + n * 65 + k8; u32x4 w;
        w.x = cvt_pk_bf16(tp[0], tp[1]); w.y = cvt_pk_bf16(tp[2], tp[3]); w.z = cvt_pk_bf16(tp[4], tp[5]); w.w = cvt_pk_bf16(tp[6], tp[7]);
        const int nn = n0 + n; int row;
        if (rowmode == 1) row = (nn >> 7) * 256 + (nn & 127);
        else if (rowmode == 2) row = (nn >> 7) * 256 + 128 + (nn & 127);
        else if (rowmode == 3) row = nn < 1024 ? nn : (nn < 2048 ? nn + 1024 : nn - 1024);
        else row = nn;
        *(u32x4*)(dst + (size_t)row * ldd + k0 + k8) = w; }
    __syncthreads();
}

__device__ __forceinline__ void weight_tile(const Params& P, int t, float* T) {
    unsigned char* ws = P.ws;
    {
        int j = t; const float* src; int ldsrc, nkt, nnt; bf16_t* dst; int ldd; const float* gain = nullptr; int rowmode = 0;
        if (j < 64) { const int gi = j >> 4; j &= 15; src = P.in[10] + (size_t)gi * 65536; ldsrc = 256; nkt = 4; nnt = 4; dst = (bf16_t*)(ws + O_WP) + (size_t)gi * 65536; ldd = 256; }
        else if ((j -= 64) < 2816) { const int q = j / 704; j %= 704; const int layer = q >> 1, up = q & 1; src = P.in[up ? 19 : 18] + (size_t)layer * 1024 * 2816; ldsrc = 2816; nkt = 16; nnt = 44;
            dst = (bf16_t*)(ws + O_WGU) + (size_t)layer * 5632 * 1024; ldd = 1024; gain = P.in[7] + layer * 1024; rowmode = 1 + up; }
        else if ((j -= 2816) < 1408) { const int layer = j / 704; j %= 704; src = P.in[20] + (size_t)layer * 2816 * 1024; ldsrc = 1024; nkt = 44; nnt = 16; dst = (bf16_t*)(ws + O_WD) + (size_t)layer * 1024 * 2816; ldd = 2816; }
        else if ((j -= 1408) < 512) { const int layer = j >> 8; j &= 255; src = P.in[22] + (size_t)layer * 1024 * 1024; ldsrc = 1024; nkt = 16; nnt = 16; dst = (bf16_t*)(ws + O_WPG) + (size_t)layer * 1024 * 1024; ldd = 1024; gain = P.in[8] + layer * 1024; }
        else if ((j -= 512) < 128) { const int layer = j >> 6; j &= 63; src = P.in[21] + (size_t)layer * 256 * 1024; ldsrc = 1024; nkt = 4; nnt = 16; dst = (bf16_t*)(ws + O_WPP) + (size_t)layer * 1024 * 256; ldd = 256; }
        else if ((j -= 128) < 768) { src = P.in[13]; ldsrc = GIN; nkt = 16; nnt = 48; dst = (bf16_t*)(ws + O_WIN); ldd = 1024; gain = P.in[6] + 1024; rowmode = 3; }
        else { j -= 768; src = P.in[17]; ldsrc = 1024; nkt = 16; nnt = 16; dst = (bf16_t*)(ws + O_WO); ldd = 1024; }
        const int kt = j / nnt, ntile = j % nnt; (void)nkt;
        transpose_tile(src, ldsrc, kt * 64, ntile * 64, dst, ldd, gain, rowmode, T);
    }
}
constexpr int N_EARLY = 3264, N_DEFER = 2688;
__device__ __forceinline__ int early_tile(int k) { if (k < 1472) return k; k -= 1472; if (k < 704) return 2880 + k; k -= 704; if (k < 256) return 4288 + k; k -= 256; if (k < 64) return 4800 + k; k -= 64; return 4928 + k; }
__device__ __forceinline__ int defer_tile(int k) { if (k < 1408) return 1472 + k; k -= 1408; if (k < 704) return 3584 + k; k -= 704; if (k < 256) return 4544 + k; k -= 256; if (k < 64) return 4864 + k; k -= 64; return 5696 + k; }
__device__ __forceinline__ void prep_weights(const Params& P, float* T) {
    unsigned char* ws = P.ws;
    if (gridDim.x == 256) {
        if (blockIdx.x < 16) { for (int k = N_EARLY - 128 + blockIdx.x; k < N_EARLY; k += 16) weight_tile(P, early_tile(k), T); }
        else { for (int k = blockIdx.x - 16; k < N_EARLY - 128; k += 240) weight_tile(P, early_tile(k), T); }
    } else
        for (int k = blockIdx.x; k < N_EARLY; k += gridDim.x) weight_tile(P, early_tile(k), T);
    if (gridDim.x != 256) for (int k = blockIdx.x; k < N_DEFER; k += gridDim.x) weight_tile(P, defer_tile(k), T);
    for (int i = blockIdx.x * NT + threadIdx.x; i < 16 * 1024; i += gridDim.x * NT) { const int n = i >> 10, k = i & 1023;
        const float v = P.in[13][(size_t)k * GIN + 3072 + n] * P.in[6][1024 + k]; ((bf16_t*)(ws + O_WGR))[i] = (bf16_t)(cvt_pk_bf16(v, 0.f) & 0xffffu); }
    for (int i = blockIdx.x * NT + threadIdx.x; i < 6 * M; i += gridDim.x * NT) ((float*)(ws + O_SSQ))[i] = 0.f;
}

__device__ __forceinline__ void convert_p(const Params& P, int layer, bf16_t* dst) {
    const f32x4* pp = (const f32x4*)(P.in[4] + (size_t)layer * MP_ROWS * PLE); const f32x4* ps = (const f32x4*)(P.in[5] + (size_t)layer * MS_ROWS * PLE);
    constexpr int n4 = M * PLE / 4, np4 = MP_ROWS * PLE / 4;
    const int stride = gridDim.x * NT;
    for (int i0 = blockIdx.x * NT + threadIdx.x; i0 < n4; i0 += 8 * stride) {
        f32x4 v[8];
#pragma unroll
        for (int j = 0; j < 8; ++j) { int i = i0 + j * stride; i = i < n4 ? i : n4 - 1; const f32x4* src = i < np4 ? pp + i : ps + (i - np4); v[j] = *src; }
#pragma unroll
        for (int j = 0; j < 8; ++j) { const int i = i0 + j * stride; if (i < n4) { u32x2 w; w.x = cvt_pk_bf16(v[j][0], v[j][1]); w.y = cvt_pk_bf16(v[j][2], v[j][3]); ((u32x2*)dst)[i] = w; } }
    }
}

template <int W> __device__ __forceinline__ void pool_diffs_w(const Params& P, float* lf) {
    const int tid = threadIdx.x, wid = tid >> 6, lane = tid & 63;
    bf16_t* Dm = (bf16_t*)(P.ws + O_DM);
    float* wsum = lf;
    float* rinv = lf + 128;
    for (int it = blockIdx.x; it < 256 + 16; it += gridDim.x) {
        const bool smp = it >= 256; const int s = smp ? it - 256 : it >> 6, t0 = smp ? 0 : (it & 63) * 64, ngrp = smp ? 2 : 5;
        const int ch = tid * 2; constexpr float iw = 1.0f / (float)W; const f32x2 gn = *(const f32x2*)(P.in[6] + ch);
        float r0[16], r1[16], run0 = 0.f, run1 = 0.f;
#pragma unroll
        for (int i = 0; i < 16; ++i) { r0[i] = 0.f; r1[i] = 0.f; }
        f32x2 xv[16], xn[16];
#define POOL_LOAD(dst, g_) do { _Pragma("unroll") for (int i = 0; i < 16; ++i) { const int rel = (g_) * 16 + i - 16, t = t0 + rel; \
                const float* src_ = smp ? (rel >= 0 ? P.in[1] + (size_t)(s * 16 + rel) * D : P.in[2] + (size_t)(s * 15 + (rel + 15 > 0 ? rel + 15 : 0)) * D) : P.in[0] + (size_t)(s * SEQ + (t > 0 ? t : 0)) * D; \
                f32x2 v = *(const f32x2*)(src_ + ch);                       \
                const bool ok_ = smp ? (rel >= -15) : (t >= 0); if (!ok_) v = (f32x2){0.f, 0.f}; \
                dst[i] = v; } } while (0)
        POOL_LOAD(xv, 0);
        for (int grp = 0; grp < ngrp; ++grp) {
            if (grp + 1 < ngrp) POOL_LOAD(xn, grp + 1);
            float q8[8], q4[4], q2[2], q1;
#pragma unroll
            for (int j = 0; j < 8; ++j) { const float e = xv[2 * j].x * xv[2 * j].x + xv[2 * j].y * xv[2 * j].y, o = xv[2 * j + 1].x * xv[2 * j + 1].x + xv[2 * j + 1].y * xv[2 * j + 1].y;
                const bool hi = lane & 1; q8[j] = (hi ? o : e) + __shfl_xor(hi ? e : o, 1); }
#pragma unroll
            for (int j = 0; j < 4; ++j) { const bool hi = lane & 2; q4[j] = (hi ? q8[2 * j + 1] : q8[2 * j]) + __shfl_xor(hi ? q8[2 * j] : q8[2 * j + 1], 2); }
#pragma unroll
            for (int j = 0; j < 2; ++j) { const bool hi = lane & 4; q2[j] = (hi ? q4[2 * j + 1] : q4[2 * j]) + __shfl_xor(hi ? q4[2 * j] : q4[2 * j + 1], 4); }
            { const bool hi = lane & 8; q1 = (hi ? q2[1] : q2[0]) + __shfl_xor(hi ? q2[0] : q2[1], 8); }
            q1 += __shfl_xor(q1, 16); q1 += __shfl_xor(q1, 32);
            if (lane < 16) wsum[wid * 16 + lane] = q1;
            __syncthreads();
            if (tid < 16) { float tot = 0.f;
#pragma unroll
                for (int w8 = 0; w8 < 8; ++w8) tot += wsum[w8 * 16 + tid];
                rinv[tid] = rinv_of(tot); }
            __syncthreads();
#pragma unroll
            for (int i = 0; i < 16; ++i) { const int rel = grp * 16 + i - 16, t = t0 + rel;
                float a0, a1;
                if (smp && rel < 0) { a0 = xv[i].x; a1 = xv[i].y; } else { const float ri = rinv[i]; a0 = xv[i].x * ri * gn.x; a1 = xv[i].y * ri * gn.y; }
                run0 += a0 - r0[(i - W) & 15]; run1 += a1 - r1[(i - W) & 15];
                r0[i] = a0; r1[i] = a1;
                if (rel >= 0) {
                    const float s0 = run0, s1 = run1;
                    const float ic = (smp || t + 1 >= W) ? iw : 1.0f / (float)(t + 1);
                    const float d0 = s0 * ic - a0, d1 = s1 * ic - a1;
                    const size_t grow = smp ? (size_t)MP_ROWS + s * 16 + rel : (size_t)s * SEQ + t;
                    *(unsigned*)(Dm + grow * D + ch) = cvt_pk_bf16(d0, d1);
                    if (smp) { if (rel >= 1) *(f32x2*)(P.out + OUT_PSS + (size_t)(s * 15 + rel - 1) * D + ch) = (f32x2){a0, a1}; }
                    else if (t >= SEQ - 15) *(f32x2*)(P.out + OUT_PSP + (size_t)(s * 15 + t - (SEQ - 15)) * D + ch) = (f32x2){a0, a1};
                } }
#pragma unroll
            for (int i = 0; i < 16; ++i) xv[i] = xn[i];
        }
#undef POOL_LOAD
        __syncthreads();
    }
}
__device__ __forceinline__ void pool_diffs(const Params& P, float* lf) {
    const int g = __builtin_amdgcn_readfirstlane(threadIdx.x >> 7);
    if (g == 0) pool_diffs_w<2>(P, lf); else if (g == 1) pool_diffs_w<4>(P, lf); else if (g == 2) pool_diffs_w<8>(P, lf); else pool_diffs_w<16>(P, lf);
}

__device__ __forceinline__ void gr_pass(const bf16_t* hb, const bf16_t* WgrT, const float* ssq_in, float* gr) {
    const int lane = threadIdx.x & 63, wid = threadIdx.x >> 6, fr = lane & 15, fq = lane >> 4;
    for (int gidx = blockIdx.x * 8 + wid; gidx < M / 16; gidx += gridDim.x * 8) {
        const int r0 = gidx * 16; f32x4 acc = (f32x4){0.f, 0.f, 0.f, 0.f};
        const bf16_t* ap = hb + (size_t)(r0 + fr) * D + 8 * fq; const bf16_t* bp = WgrT + (size_t)fr * D + 8 * fq;
#pragma unroll 8
        for (int s = 0; s < 32; ++s) { const bf16x8 a = *(const bf16x8*)(ap + 32 * s), b = *(const bf16x8*)(bp + 32 * s); acc = __builtin_amdgcn_mfma_f32_16x16x32_bf16(a, b, acc, 0, 0, 0); }
#pragma unroll
        for (int j = 0; j < 4; ++j) { const int r = r0 + 4 * fq + j; gr[(size_t)r * 16 + fr] = acc[j] * rinv_of(ssq_in[r]); }
    }
}

struct Item { int row0, L, h, j; };
__device__ __forceinline__ Item decode_item(int it) { Item I; if (it < 1024) { const int b = it >> 8; I.h = (it >> 6) & 3; I.row0 = b * SEQ + (it & 63) * 64; I.L = 64; } else { const int j = it - 1024; I.h = j & 3; I.row0 = MP_ROWS + (j >> 2) * 16; I.L = 16; } I.j = it; return I; }

constexpr int L_GRS = 0;
constexpr int L_BSH = 4096;
constexpr int L_QT = 36864;
constexpr int L_KT = 38912;
constexpr int L_QD = 38912;
constexpr int L_KIN = 56320;
constexpr int L_PSH = 73728;
constexpr int L_SSQ = 82944;

__device__ __forceinline__ void compute_b(const Params& P, const Item& I, unsigned char* lds) {
    const int tid = threadIdx.x; float* grs = (float*)(lds + L_GRS); float* bsh = (float*)(lds + L_BSH); float* qt = (float*)(lds + L_QT);
    const float* gr = (const float*)(P.ws + O_GR);
    if (tid < 256) { const int t = tid >> 2, tc = t < I.L ? t : I.L - 1; f32x4 v = *(const f32x4*)(gr + (size_t)(I.row0 + tc) * 16 + (tid & 3) * 4); if (t >= I.L) v = (f32x4){0.f, 0.f, 0.f, 0.f}; *(f32x4*)(grs + tid * 4) = v; }
    const int dk = tid & 127, tq = tid >> 7;
    float wc[16];
#pragma unroll
    for (int r = 0; r < 16; ++r) wc[r] = P.in[14][r * KEYD + I.h * DK + dk];
    const float bias = P.in[15][I.h * DK + dk];
    __syncthreads();
    float bl[16]; float run = 0.f;
#pragma unroll
    for (int i = 0; i < 16; ++i) { const int t = tq * 16 + i; float a = bias;
#pragma unroll
        for (int r = 0; r < 16; ++r) a += grs[t * 16 + r] * wc[r];
        const float ls = fminf(a, 0.f) - __logf(1.0f + __expf(-fabsf(a)));
        run += (t < I.L) ? ls * (1.0f / 16.0f) : 0.f; bl[i] = run; }
    qt[tq * 128 + dk] = run;
    __syncthreads();
    float off = 0.f;
#pragma unroll
    for (int q = 0; q < 3; ++q) if (q < tq) off += qt[q * 128 + dk];
#pragma unroll
    for (int i = 0; i < 16; ++i) bsh[(tq * 16 + i) * 128 + dk] = bl[i] + off;
    __syncthreads();
}

__device__ __forceinline__ void gla_g1(const Params& P, unsigned char* lds) {
    const int tid = threadIdx.x, wid = tid >> 6, lane = tid & 63, fr = lane & 15, fq = lane >> 4;
    const bf16_t* kg = (const bf16_t*)(P.ws + O_K); const bf16_t* vT = (const bf16_t*)(P.ws + O_VT);
    bf16_t* KVT = (bf16_t*)(P.ws + O_KVT); float* dec = (float*)(P.ws + O_DEC);
    const float* bsh = (const float*)(lds + L_BSH); bf16_t* kT = (bf16_t*)(lds + L_KT);
    for (int it = blockIdx.x; it < NITEM; it += gridDim.x) {
        const Item I = decode_item(it);
        compute_b(P, I, lds);
        { const int dk = tid & 127, tq = tid >> 7; const float blast = bsh[63 * 128 + dk]; float ke[16];
            bf16_t kraw[16];
#pragma unroll
            for (int i = 0; i < 16; ++i) { const int t = tq * 16 + i, tc = t < I.L ? t : I.L - 1; kraw[i] = kg[(size_t)(I.row0 + tc) * KEYD + I.h * DK + dk]; }
#pragma unroll
            for (int i = 0; i < 16; ++i) { const int t = tq * 16 + i; const float kv = bf1(kraw[i]) * __expf(blast - bsh[t * 128 + dk]); ke[i] = t < I.L ? kv : 0.f; }
            u32x4 w0, w1; w0.x = cvt_pk_bf16(ke[0], ke[1]); w0.y = cvt_pk_bf16(ke[2], ke[3]); w0.z = cvt_pk_bf16(ke[4], ke[5]); w0.w = cvt_pk_bf16(ke[6], ke[7]);
            w1.x = cvt_pk_bf16(ke[8], ke[9]); w1.y = cvt_pk_bf16(ke[10], ke[11]); w1.z = cvt_pk_bf16(ke[12], ke[13]); w1.w = cvt_pk_bf16(ke[14], ke[15]);
            *(u32x4*)(kT + dk * 72 + tq * 16) = w0; *(u32x4*)(kT + dk * 72 + tq * 16 + 8) = w1;
            if (tq == 0) dec[(size_t)it * 128 + dk] = __expf(blast); }
        __syncthreads();
        f32x4 acc[8][2];
#pragma unroll
        for (int mt = 0; mt < 8; ++mt) { acc[mt][0] = (f32x4){0.f, 0.f, 0.f, 0.f}; acc[mt][1] = (f32x4){0.f, 0.f, 0.f, 0.f}; }
#pragma unroll
        for (int s = 0; s < 2; ++s) { const int t8 = 32 * s + 8 * fq;
            if (32 * s < I.L) {
                bf16x8 bfr[2];
#pragma unroll
                for (int nt = 0; nt < 2; ++nt) { const int tc = t8 < I.L ? t8 : 0; bfr[nt] = *(const bf16x8*)(vT + (size_t)(I.h * DV + 32 * wid + 16 * nt + fr) * MPAD + I.row0 + tc); if (t8 >= I.L) bfr[nt] = (bf16x8){0, 0, 0, 0, 0, 0, 0, 0}; }
#pragma unroll
                for (int mt = 0; mt < 8; ++mt) { const bf16x8 a = *(const bf16x8*)(kT + (16 * mt + fr) * 72 + t8);
                    acc[mt][0] = __builtin_amdgcn_mfma_f32_16x16x32_bf16(a, bfr[0], acc[mt][0], 0, 0, 0); acc[mt][1] = __builtin_amdgcn_mfma_f32_16x16x32_bf16(a, bfr[1], acc[mt][1], 0, 0, 0); } } }
#pragma unroll
        for (int mt = 0; mt < 8; ++mt)
#pragma unroll
            for (int nt = 0; nt < 2; ++nt) { u32x2 w; w.x = cvt_pk_bf16(acc[mt][nt][0], acc[mt][nt][1]); w.y = cvt_pk_bf16(acc[mt][nt][2], acc[mt][nt][3]);
                *(u32x2*)(KVT + ((size_t)it * 256 + 32 * wid + 16 * nt + fr) * 128 + 16 * mt + 4 * fq) = w; }
        __syncthreads();
    }
}

__device__ __forceinline__ void gla_g2(const Params& P, unsigned char* lds) {
    const int tid = threadIdx.x; bf16_t* KVT = (bf16_t*)(P.ws + O_KVT); const float* dec = (const float*)(P.ws + O_DEC); float* tile = (float*)lds;
    const int dvl = tid >> 5, dk4 = (tid & 31) * 4, odk = tid >> 2, odv4 = (tid & 3) * 4;
    for (int u = blockIdx.x; u < 256; u += gridDim.x) {
        const int bh = u >> 4, dvb = u & 15, dv = dvb * 16 + dvl; f32x4 S = (f32x4){0.f, 0.f, 0.f, 0.f};
        for (int cb = 0; cb < 8; ++cb) {
            u32x2 kv[8]; f32x4 d[8];
#pragma unroll
            for (int j = 0; j < 8; ++j) { const int it = bh * 64 + cb * 8 + j; kv[j] = *(const u32x2*)(KVT + ((size_t)it * 256 + dv) * 128 + dk4); d[j] = *(const f32x4*)(dec + (size_t)it * 128 + dk4); }
#pragma unroll
            for (int j = 0; j < 8; ++j) { const int it = bh * 64 + cb * 8 + j; u32x2 w; w.x = cvt_pk_bf16(S[0], S[1]); w.y = cvt_pk_bf16(S[2], S[3]);
                *(u32x2*)(KVT + ((size_t)it * 256 + dv) * 128 + dk4) = w;
                S[0] = d[j][0] * S[0] + bf_lo(kv[j].x); S[1] = d[j][1] * S[1] + bf_hi(kv[j].x); S[2] = d[j][2] * S[2] + bf_lo(kv[j].y); S[3] = d[j][3] * S[3] + bf_hi(kv[j].y); }
        }
        __syncthreads();
#pragma unroll
        for (int i = 0; i < 4; ++i) tile[(dk4 + i) * 17 + dvl] = S[i];
        __syncthreads();
        { f32x4 o; o[0] = tile[odk * 17 + odv4]; o[1] = tile[odk * 17 + odv4 + 1]; o[2] = tile[odk * 17 + odv4 + 2]; o[3] = tile[odk * 17 + odv4 + 3];
            *(f32x4*)(P.out + OUT_GSP + ((size_t)bh * 128 + odk) * 256 + dvb * 16 + odv4) = o; }
    }
    for (int u = blockIdx.x; u < 1024; u += gridDim.x) {
        const int j = u >> 4, dvb = u & 15, it = 1024 + j, dv = dvb * 16 + dvl;
        __syncthreads();
        { const f32x4 v = *(const f32x4*)(P.in[3] + ((size_t)j * 128 + odk) * 256 + dvb * 16 + odv4);
#pragma unroll
            for (int i = 0; i < 4; ++i) tile[odk * 17 + odv4 + i] = v[i]; }
        __syncthreads();
        f32x4 s, f;
#pragma unroll
        for (int i = 0; i < 4; ++i) s[i] = tile[(dk4 + i) * 17 + dvl];
        const u32x2 kv = *(const u32x2*)(KVT + ((size_t)it * 256 + dv) * 128 + dk4); const f32x4 d = *(const f32x4*)(dec + (size_t)it * 128 + dk4);
        { u32x2 w; w.x = cvt_pk_bf16(s[0], s[1]); w.y = cvt_pk_bf16(s[2], s[3]); *(u32x2*)(KVT + ((size_t)it * 256 + dv) * 128 + dk4) = w; }
        f[0] = d[0] * s[0] + bf_lo(kv.x); f[1] = d[1] * s[1] + bf_hi(kv.x); f[2] = d[2] * s[2] + bf_lo(kv.y); f[3] = d[3] * s[3] + bf_hi(kv.y);
        __syncthreads();
#pragma unroll
        for (int i = 0; i < 4; ++i) tile[(dk4 + i) * 17 + dvl] = f[i];
        __syncthreads();
        { f32x4 o; o[0] = tile[odk * 17 + odv4]; o[1] = tile[odk * 17 + odv4 + 1]; o[2] = tile[odk * 17 + odv4 + 2]; o[3] = tile[odk * 17 + odv4 + 3];
            *(f32x4*)(P.out + OUT_GSS + ((size_t)j * 128 + odk) * 256 + dvb * 16 + odv4) = o; }
    }
}

__device__ __forceinline__ void gla_g3(const Params& P, unsigned char* lds) {
    const int tid = threadIdx.x, wid = tid >> 6, lane = tid & 63, fr = lane & 15, fq = lane >> 4;
    const bf16_t* qg = (const bf16_t*)(P.ws + O_Q); const bf16_t* kg = (const bf16_t*)(P.ws + O_K); const bf16_t* gg = (const bf16_t*)(P.ws + O_G);
    const bf16_t* vT = (const bf16_t*)(P.ws + O_VT); const bf16_t* SpT = (const bf16_t*)(P.ws + O_KVT); bf16_t* og = (bf16_t*)(P.ws + O_OG);
    const float* bsh = (const float*)(lds + L_BSH); bf16_t* qd = (bf16_t*)(lds + L_QD); bf16_t* kin = (bf16_t*)(lds + L_KIN); bf16_t* Psh = (bf16_t*)(lds + L_PSH); float* ssh = (float*)(lds + L_SSQ);
    bf16x8 sfp[4][2];
#define G3_LOAD_S(it_) do { _Pragma("unroll") for (int s_ = 0; s_ < 4; ++s_) _Pragma("unroll") for (int nt_ = 0; nt_ < 2; ++nt_) \
        sfp[s_][nt_] = *(const bf16x8*)(SpT + ((size_t)(it_) * 256 + 32 * wid + 16 * nt_ + fr) * 128 + 32 * s_ + 8 * fq); } while (0)
    if ((int)blockIdx.x < NITEM) G3_LOAD_S(blockIdx.x);
    for (int it = blockIdx.x; it < NITEM; it += gridDim.x) {
        const Item I = decode_item(it);
        compute_b(P, I, lds);
#pragma unroll
        for (int p = 0; p < 2; ++p) { const int idx = tid + p * NT, t = idx >> 4, c8 = (idx & 15) * 8; u32x4 qo = (u32x4){0u, 0u, 0u, 0u}, ko = (u32x4){0u, 0u, 0u, 0u};
            const int tcl = t < I.L ? t : I.L - 1; const u32x4 qw = *(const u32x4*)(qg + (size_t)(I.row0 + tcl) * KEYD + I.h * DK + c8), kw = *(const u32x4*)(kg + (size_t)(I.row0 + tcl) * KEYD + I.h * DK + c8);
            if (t < I.L) {
                const f32x4 b0 = *(const f32x4*)(bsh + t * 128 + c8), b1 = *(const f32x4*)(bsh + t * 128 + c8 + 4);
                float e[8], ei[8];
#pragma unroll
                for (int j = 0; j < 4; ++j) { e[j] = __expf(b0[j]); e[4 + j] = __expf(b1[j]); ei[j] = __expf(-b0[j]); ei[4 + j] = __expf(-b1[j]); }
                qo.x = cvt_pk_bf16(bf_lo(qw.x) * e[0], bf_hi(qw.x) * e[1]); qo.y = cvt_pk_bf16(bf_lo(qw.y) * e[2], bf_hi(qw.y) * e[3]); qo.z = cvt_pk_bf16(bf_lo(qw.z) * e[4], bf_hi(qw.z) * e[5]); qo.w = cvt_pk_bf16(bf_lo(qw.w) * e[6], bf_hi(qw.w) * e[7]);
                ko.x = cvt_pk_bf16(bf_lo(kw.x) * ei[0], bf_hi(kw.x) * ei[1]); ko.y = cvt_pk_bf16(bf_lo(kw.y) * ei[2], bf_hi(kw.y) * ei[3]); ko.z = cvt_pk_bf16(bf_lo(kw.z) * ei[4], bf_hi(kw.z) * ei[5]); ko.w = cvt_pk_bf16(bf_lo(kw.w) * ei[6], bf_hi(kw.w) * ei[7]); }
            *(u32x4*)(qd + t * 136 + c8) = qo; *(u32x4*)(kin + t * 136 + c8) = ko; }
        __syncthreads();
        { const int lt = wid >> 1;
#pragma unroll
            for (int q = 0; q < 2; ++q) { const int mt = 2 * (wid & 1) + q; f32x4 a4 = (f32x4){0.f, 0.f, 0.f, 0.f};
                if (mt <= lt) {
#pragma unroll
                    for (int s = 0; s < 4; ++s) { const bf16x8 a = *(const bf16x8*)(qd + (16 * lt + fr) * 136 + 32 * s + 8 * fq), b = *(const bf16x8*)(kin + (16 * mt + fr) * 136 + 32 * s + 8 * fq);
                        a4 = __builtin_amdgcn_mfma_f32_16x16x32_bf16(a, b, a4, 0, 0, 0); } }
                const int mcol = 16 * mt + fr;
#pragma unroll
                for (int j = 0; j < 4; ++j) { const int l = 16 * lt + 4 * fq + j; const float pv = (mcol <= l) ? a4[j] : 0.f; Psh[l * 72 + mcol] = (bf16_t)(cvt_pk_bf16(pv, 0.f) & 0xffffu); } } }
        __syncthreads();
        f32x4 acc[2][4];
#pragma unroll
        for (int nt = 0; nt < 2; ++nt)
#pragma unroll
            for (int lt = 0; lt < 4; ++lt) acc[nt][lt] = (f32x4){0.f, 0.f, 0.f, 0.f};
#pragma unroll
        for (int s = 0; s < 2; ++s) { const int t8 = 32 * s + 8 * fq;
            if (32 * s < I.L) {
                bf16x8 vf[2];
#pragma unroll
                for (int nt = 0; nt < 2; ++nt) { const int tc = t8 < I.L ? t8 : 0; vf[nt] = *(const bf16x8*)(vT + (size_t)(I.h * DV + 32 * wid + 16 * nt + fr) * MPAD + I.row0 + tc); if (t8 >= I.L) vf[nt] = (bf16x8){0, 0, 0, 0, 0, 0, 0, 0}; }
#pragma unroll
                for (int lt = 0; lt < 4; ++lt) { const bf16x8 pf = *(const bf16x8*)(Psh + (16 * lt + fr) * 72 + t8);
                    acc[0][lt] = __builtin_amdgcn_mfma_f32_16x16x32_bf16(vf[0], pf, acc[0][lt], 0, 0, 0); acc[1][lt] = __builtin_amdgcn_mfma_f32_16x16x32_bf16(vf[1], pf, acc[1][lt], 0, 0, 0); } } }
#pragma unroll
        for (int s = 0; s < 4; ++s) { const int k8 = 32 * s + 8 * fq;
#pragma unroll
            for (int lt = 0; lt < 4; ++lt) { const bf16x8 qf = *(const bf16x8*)(qd + (16 * lt + fr) * 136 + k8);
                acc[0][lt] = __builtin_amdgcn_mfma_f32_16x16x32_bf16(sfp[s][0], qf, acc[0][lt], 0, 0, 0); acc[1][lt] = __builtin_amdgcn_mfma_f32_16x16x32_bf16(sfp[s][1], qf, acc[1][lt], 0, 0, 0); } }
        if (it + (int)gridDim.x < NITEM) G3_LOAD_S(it + gridDim.x);
#pragma unroll
        for (int lt = 0; lt < 4; ++lt) { float ss = 0.f;
#pragma unroll
            for (int nt = 0; nt < 2; ++nt) ss += (acc[nt][lt][0] * acc[nt][lt][0] + acc[nt][lt][1] * acc[nt][lt][1]) + (acc[nt][lt][2] * acc[nt][lt][2] + acc[nt][lt][3] * acc[nt][lt][3]);
            ss += __shfl_xor(ss, 16); ss += __shfl_xor(ss, 32);
            if (fq == 0) ssh[wid * 64 + 16 * lt + fr] = ss; }
        u32x2 gwp[4][2];
#pragma unroll
        for (int lt = 0; lt < 4; ++lt)
#pragma unroll
            for (int nt = 0; nt < 2; ++nt) { const int l = 16 * lt + fr, lc = l < I.L ? l : I.L - 1;
                gwp[lt][nt] = *(const u32x2*)(gg + (size_t)(I.row0 + lc) * D + I.h * DV + 32 * wid + 16 * nt + 4 * fq); }
        __syncthreads();
#pragma unroll
        for (int lt = 0; lt < 4; ++lt) { const int l = 16 * lt + fr;
            if (l < I.L) { float tot = 0.f;
#pragma unroll
                for (int w8 = 0; w8 < 8; ++w8) tot += ssh[w8 * 64 + l];
                const float ro = rsqrtf(tot * (1.0f / 256.0f) + EPS);
#pragma unroll
                for (int nt = 0; nt < 2; ++nt) { const int dvh = 32 * wid + 16 * nt + 4 * fq; const size_t off = (size_t)(I.row0 + l) * D + I.h * DV + dvh;
                    const u32x2 gw = gwp[lt][nt]; const f32x4 nw = *(const f32x4*)(P.in[16] + dvh);
                    const float o0 = acc[nt][lt][0] * ro * nw[0] * siluf_(bf_lo(gw.x)), o1 = acc[nt][lt][1] * ro * nw[1] * siluf_(bf_hi(gw.x));
                    const float o2 = acc[nt][lt][2] * ro * nw[2] * siluf_(bf_lo(gw.y)), o3 = acc[nt][lt][3] * ro * nw[3] * siluf_(bf_hi(gw.y));
                    u32x2 w; w.x = cvt_pk_bf16(o0, o1); w.y = cvt_pk_bf16(o2, o3); *(u32x2*)(og + off) = w; } } }
        __syncthreads();
    }
}

__device__ __forceinline__ void final_norm(const Params& P, float* dst, int row_lo) {
    float* h = P.out + OUT_Y; const float* ssq = (const float*)(P.ws + O_SSQ) + 5 * M; const float* nf = P.in[9];
    constexpr int n4 = M * D / 4; const int stride = gridDim.x * NT;
    for (int i0 = row_lo * (D / 4) + blockIdx.x * NT + threadIdx.x; i0 < n4; i0 += 4 * stride) {
        f32x4 v[4];
#pragma unroll
        for (int j = 0; j < 4; ++j) { const int i = i0 + j * stride; v[j] = (f32x4){0.f, 0.f, 0.f, 0.f}; if (i < n4) v[j] = ((const f32x4*)h)[i]; }
#pragma unroll
        for (int j = 0; j < 4; ++j) { const int i = i0 + j * stride; if (i < n4) { const int r = i >> 8, c4 = (i & 255) * 4; const float ri = rinv_of(ssq[r]); const f32x4 g = *(const f32x4*)(nf + c4); ((f32x4*)dst)[i] = v[j] * ri * g; } }
    }
}
__device__ __forceinline__ void fused_final_tile(const Params& P, int pm, int pn, unsigned* cnt, unsigned char* lds_f) {
    const int tid = threadIdx.x;
    asm volatile("s_waitcnt vmcnt(0)" ::: "memory");
    __syncthreads();
    if (tid == 0) {
        __hip_atomic_fetch_add(cnt + 16 * pm, 1u, __ATOMIC_RELAXED, __HIP_MEMORY_SCOPE_AGENT);
        unsigned sp = 0;
        while (__hip_atomic_load(cnt + 16 * pm, __ATOMIC_RELAXED, __HIP_MEMORY_SCOPE_AGENT) < 4u) { __builtin_amdgcn_s_sleep(2); if (++sp > (1u << 22)) break; }
    }
    __syncthreads();
    float* h = P.out + OUT_Y; float* ssq = (float*)(P.ws + O_SSQ) + 5 * M; const float* nf = P.in[9];
    float* rs = (float*)lds_f;
    if (tid < 256) rs[tid] = rinv_of(__hip_atomic_load(ssq + pm * 256 + tid, __ATOMIC_RELAXED, __HIP_MEMORY_SCOPE_AGENT));
    __syncthreads();
    const int c4 = (tid & 63) * 4; const f32x4 g = *(const f32x4*)(nf + pn * 256 + c4);
    for (int i0 = 0; i0 < 32; i0 += 8) {
        f32x4 v[8];
#pragma unroll
        for (int j = 0; j < 8; ++j) { const int row = (i0 + j) * 8 + (tid >> 6); v[j] = *(const f32x4*)(h + (size_t)(pm * 256 + row) * D + pn * 256 + c4); }
#pragma unroll
        for (int j = 0; j < 8; ++j) { const int row = (i0 + j) * 8 + (tid >> 6); *(f32x4*)(h + (size_t)(pm * 256 + row) * D + pn * 256 + c4) = v[j] * rs[row] * g; } }
    __syncthreads();
}

__device__ __forceinline__ void fused_final_sample(const Params& P, int rt, int ct, unsigned* cnt) {
    const int tid = threadIdx.x;
    asm volatile("s_waitcnt vmcnt(0)" ::: "memory");
    __syncthreads();
    if (tid == 0) {
        __hip_atomic_fetch_add(cnt + 16 * rt, 1u, __ATOMIC_RELAXED, __HIP_MEMORY_SCOPE_AGENT);
        unsigned sp = 0;
        while (__hip_atomic_load(cnt + 16 * rt, __ATOMIC_RELAXED, __HIP_MEMORY_SCOPE_AGENT) < 32u) { __builtin_amdgcn_s_sleep(2); if (++sp > (1u << 22)) break; }
    }
    __syncthreads();
    if (tid < 256) { float* h = P.out + OUT_Y; float* ssq = (float*)(P.ws + O_SSQ) + 5 * M; const float* nf = P.in[9];
        const int r = MP_ROWS + 32 * rt + (tid >> 3), c = 32 * ct + (tid & 7) * 4;
        const float ri = rinv_of(__hip_atomic_load(ssq + r, __ATOMIC_RELAXED, __HIP_MEMORY_SCOPE_AGENT));
        float* hp = h + (size_t)r * D + c; f32x4 v = *(const f32x4*)hp; const f32x4 g = *(const f32x4*)(nf + c); *(f32x4*)hp = v * ri * g; }
}

__global__ void __launch_bounds__(NT, 2) fwd_kernel(Params P) {
    extern __shared__ __attribute__((aligned(16))) unsigned char lds[];
    cg::grid_group grid = cg::this_grid();
    LAS unsigned char* ldsl = (LAS unsigned char*)lds;
    unsigned char* ws = P.ws;
    const int G = gridDim.x, bx = blockIdx.x;
    float* h = P.out + OUT_Y;
    bf16_t* hbA = (bf16_t*)(ws + O_HBA); bf16_t* hbB = (bf16_t*)(ws + O_HBB);
    float* ssq = (float*)(ws + O_SSQ);
    bf16_t* act = (bf16_t*)(ws + O_ACT); bf16_t* pp = (bf16_t*)(ws + O_PP);
    const int lo = P.ph_lo, hi = (gridDim.x == 256 && P.ph_hi == 14) ? 13 : P.ph_hi;
#define STAGGER() do { const int ns_ = (bx >> 3) & 3; for (int i_ = 0; i_ < ns_; ++i_) __builtin_amdgcn_s_sleep(31); } while (0)
    if (threadIdx.x < 4) ((unsigned*)(lds + LDS_MAIN))[threadIdx.x] = 0u;
    __syncthreads();
    const XcdBarrier xbar = xcd_barrier_post((unsigned*)(ws + O_BAR), (volatile LAS unsigned*)(ldsl + LDS_MAIN));
    if (lo > 1000) grid.sync();
#define GRID_SYNC() xcd_barrier(xbar)
#ifndef DUPMASK
#define DUPMASK 0
#endif
#define DUP(k) (((DUPMASK) >> (k)) & 1)
#define PHASE(k, ...) if (EN(k) && lo <= (k) && (k) < hi) { constexpr bool dup_ = false; (void)dup_; __VA_ARGS__ if ((k) + 1 < hi) GRID_SYNC(); } if (DUP(k) && lo <= (k) && (k) < hi) { constexpr bool dup_ = true; (void)dup_; __VA_ARGS__ GRID_SYNC(); }
    PHASE(0,
        pool_diffs(P, (float*)lds);
        __syncthreads();
        convert_p(P, 0, (bf16_t*)(ws + O_PB0));
        prep_weights(P, (float*)lds);
    )
    PHASE(1,
        { pg8::Gemm g{(const bf16_t*)(ws + O_DM), (const bf16_t*)(ws + O_WP), D, 256, 256, 256}; pg8::StaticOrder S; S.init(64, 4, G, bx);
          EpiPool E{P.in[0], P.in[1], h, hbA, P.in[11], P.in[12], ssq + (dup_ ? 6 : 0) * M}; pg8::gemm_phase(ldsl, g, S, E);
          small_gemm(lds, g.A, D, g.Bt, 256, 256, 32, 256, E); }
    )
    PHASE(2,
        { pg8::Gemm g{hbA, (const bf16_t*)(ws + O_WGU), D, D, D, 0}; pg8::StaticOrder S; S.init(65, 22, G, bx);
          EpiGU E{act, ssq + 0 * M}; pg8::gemm_phase(ldsl, g, S, E); }
        if (G == 256 ? bx >= 150 : true) { const int gs = G == 256 ? 106 : G, gc = G == 256 ? bx - 150 : bx;
          pg8::Gemm g{(const bf16_t*)(ws + O_PB0), (const bf16_t*)(ws + O_WPP), PLE, PLE, PLE, 0}; pg8::StaticOrder S; S.init(64, 4, gs, gc);
          EpiBf E{pp, D}; pg8::gemm_phase(ldsl, g, S, E);
          small_gemm(lds, g.A, PLE, g.Bt, PLE, PLE, 32, 0, E, gc, gs); }
    )
    PHASE(3,
        pg8::Gemm g{act, (const bf16_t*)(ws + O_WD), DFF, DFF, DFF, 0}; pg8::StaticOrder S; S.init(64, 4, G, bx);
        EpiRes E{h, hbB, ssq + (dup_ ? 6 : 1) * M, dup_ ? 0.f : 1.f}; pg8::gemm_phase(ldsl, g, S, E);
        small_gemm(lds, g.A, DFF, g.Bt, DFF, DFF, 32, 0, E);
    )
    PHASE(4,
        pg8::Gemm g{hbB, (const bf16_t*)(ws + O_WPG), D, D, D, 0}; pg8::StaticOrder S; S.init(64, 4, G, bx);
        EpiPle E{h, hbA, pp, ssq + 1 * M, ssq + (dup_ ? 6 : 2) * M, dup_ ? 0.f : 1.f}; pg8::gemm_phase(ldsl, g, S, E);
        small_gemm(lds, g.A, D, g.Bt, D, D, 32, 0, E);
    )
    PHASE(5,
        gr_pass(hbA, (const bf16_t*)(ws + O_WGR), ssq + 2 * M, (float*)(ws + O_GR));
        __syncthreads();
        { pg8::Gemm g{hbA, (const bf16_t*)(ws + O_WIN), D, D, D, 0}; pg8::StaticOrder S; S.init(64, 8, G, bx);
          EpiQKG E{(bf16_t*)(ws + O_Q), (bf16_t*)(ws + O_K), (bf16_t*)(ws + O_G), ssq + 2 * M}; pg8::gemm_phase(ldsl, g, S, E);
          small_gemm(lds, g.A, D, g.Bt, D, D, 64, 0, E); }
        { pg8::Gemm g{(const bf16_t*)(ws + O_WIN) + (size_t)2048 * 1024, hbA, D, D, D, 0}; pg8::StaticOrder S; S.init(4, 64, G, bx);
          EpiVT E{(bf16_t*)(ws + O_VT), ssq + 2 * M}; pg8::gemm_phase(ldsl, g, S, E);
          small_gemm(lds, hbA, D, g.A, D, D, 32, 0, E); }
    )
    PHASE(6, gla_g1(P, lds); if (!dup_ && G == 256 && bx >= 64) { __syncthreads(); for (int k = bx - 64; k < N_DEFER; k += 384) weight_tile(P, defer_tile(k), (float*)lds); } )
    PHASE(7, gla_g2(P, lds); )
    PHASE(8, gla_g3(P, lds); if (!dup_ && G == 256 && bx >= 64) { __syncthreads(); for (int k = 192 + bx - 64; k < N_DEFER; k += 384) weight_tile(P, defer_tile(k), (float*)lds); } )
    PHASE(9,
        pg8::Gemm g{(const bf16_t*)(ws + O_OG), (const bf16_t*)(ws + O_WO), D, D, D, 0}; pg8::StaticOrder S; S.init(64, 4, G, bx);
        EpiRes E{h, hbB, ssq + (dup_ ? 6 : 3) * M, dup_ ? 0.f : 1.f}; pg8::gemm_phase(ldsl, g, S, E);
        small_gemm(lds, g.A, D, g.Bt, D, D, 32, 0, E);
        convert_p(P, 1, (bf16_t*)(ws + O_PB1));
    )
    PHASE(10,
        { pg8::Gemm g{hbB, (const bf16_t*)(ws + O_WGU) + (size_t)5632 * 1024, D, D, D, 0}; pg8::StaticOrder S; S.init(65, 22, G, bx);
          EpiGU E{act, ssq + 3 * M}; pg8::gemm_phase(ldsl, g, S, E); }
        if (G == 256 ? bx >= 150 : true) { const int gs = G == 256 ? 106 : G, gc = G == 256 ? bx - 150 : bx;
          pg8::Gemm g{(const bf16_t*)(ws + O_PB1), (const bf16_t*)(ws + O_WPP) + (size_t)1024 * 256, PLE, PLE, PLE, 0}; pg8::StaticOrder S; S.init(64, 4, gs, gc);
          EpiBf E{pp, D}; pg8::gemm_phase(ldsl, g, S, E);
          small_gemm(lds, g.A, PLE, g.Bt, PLE, PLE, 32, 0, E, gc, gs); }
    )
    PHASE(11,
        { pg8::Gemm g{act, (const bf16_t*)(ws + O_WD) + (size_t)1024 * 2816, DFF, DFF, DFF, 0}; pg8::StaticOrder S; S.init(64, 4, G, bx);
          EpiRes E{h, hbA, ssq + (dup_ ? 6 : 4) * M, dup_ ? 0.f : 1.f}; pg8::gemm_phase(ldsl, g, S, E);
          small_gemm(lds, g.A, DFF, g.Bt, DFF, DFF, 32, 0, E); }
    )
    PHASE(12,
        pg8::Gemm g{hbA, (const bf16_t*)(ws + O_WPG) + (size_t)1024 * 1024, D, D, D, 0}; pg8::StaticOrder S; S.init(64, 4, G, bx);
        EpiPle E{h, hbB, pp, ssq + 4 * M, ssq + (dup_ ? 6 : 5) * M, dup_ ? 0.f : 1.f}; pg8::gemm_phase(ldsl, g, S, E);
        if (!dup_ && G == 256) { pg8::Unit u; if (S.next(0, u)) fused_final_tile(P, u.pm, u.pn, (unsigned*)(ws + O_BAR) + 4096, lds); }
        small_gemm(lds, g.A, D, g.Bt, D, D, 32, 0, E);
        if (!dup_ && G == 256) fused_final_sample(P, bx & 7, bx >> 3, (unsigned*)(ws + O_BAR) + 4096 + 16 * 64);
    )
#ifdef EXTRA_SYNCS
    for (int i_ = 0; i_ < EXTRA_SYNCS; ++i_) GRID_SYNC();
#endif
    if (G != 256) { PHASE(13, final_norm(P, dup_ ? (float*)(ws + O_ACT) : P.out + OUT_Y, 0); ) }
}

extern "C" void kernel_launch(void* const* d_in, const int* in_sizes, int n_in, void* d_out, int out_size, void* d_ws, size_t ws_size, hipStream_t stream) {
    static int grid_blocks = 0;
    if (!grid_blocks) {
        int dev = 0, cus = 0, per_cu = 0;
        hipGetDevice(&dev);
        hipDeviceGetAttribute(&cus, hipDeviceAttributeMultiprocessorCount, dev);
        if (hipFuncSetAttribute((const void*)fwd_kernel, hipFuncAttributeMaxDynamicSharedMemorySize, LDS_BYTES) != hipSuccess) fprintf(stderr, "hipFuncSetAttribute failed\n");
        if (hipOccupancyMaxActiveBlocksPerMultiprocessor(&per_cu, (const void*)fwd_kernel, NT, LDS_BYTES) != hipSuccess || per_cu < 1) { fprintf(stderr, "occupancy query: %d\n", per_cu); per_cu = 1; }
        (void)hipGetLastError();
        grid_blocks = cus;
        if (ws_size < WS_NEED) fprintf(stderr, "workspace too small: %zu < %zu\n", ws_size, (size_t)WS_NEED);
    }
    Params p{};
    for (int i = 0; i < 23; ++i) p.in[i] = (const float*)d_in[i];
    p.out = (float*)d_out; p.ws = (unsigned char*)d_ws; p.ph_lo = 0; p.ph_hi = 14;
    (void)hipMemsetAsync((unsigned char*)d_ws + O_BAR, 0, BAR_BYTES, stream);
    void* args[] = {&p};
    hipError_t e = hipLaunchCooperativeKernel((const void*)fwd_kernel, dim3(grid_blocks), dim3(NT), args, LDS_BYTES, stream);
    if (e != hipSuccess) fprintf(stderr, "cooperative launch failed: %s (grid %d)\n", hipGetErrorString(e), grid_blocks);
}
```

```cpp
#include <hip/hip_runtime.h>
#include <hip/hip_cooperative_groups.h>
#include <cstdio>
namespace cg = cooperative_groups;

#define LAS __attribute__((address_space(3)))
typedef unsigned short bf16_t;
typedef short bf16x8 __attribute__((ext_vector_type(8)));
typedef float f32x4 __attribute__((ext_vector_type(4)));
typedef float f32x2 __attribute__((ext_vector_type(2)));
typedef unsigned u32x4 __attribute__((ext_vector_type(4)));
typedef unsigned u32x2 __attribute__((ext_vector_type(2)));

constexpr int D = 1024, MP_ROWS = 16384, MS_ROWS = 256, M = MP_ROWS + MS_ROWS, SEQ = 4096, DFF = 2816, PLE = 256;
constexpr int GIN = 3088, DK = 128, DV = 256, NH = 4, KEYD = 512;
constexpr int MPAD = M + 64;
constexpr int NITEM = 1024 + 64;
constexpr float EPS = 1e-6f;
constexpr int NT = 512;
constexpr int LDS_MAIN = 131072;
constexpr int LDS_BYTES = LDS_MAIN + 16;
#ifndef PHMASK
#define PHMASK 0xFFFF
#endif
#define EN(n) (((PHMASK) >> (n)) & 1)

constexpr size_t SZ_HB = (size_t)M * D * 2;
constexpr size_t O_WP = 0;
constexpr size_t O_WGU = O_WP + 4 * 256 * 256 * 2;
constexpr size_t O_WD = O_WGU + (size_t)2 * 5632 * 1024 * 2;
constexpr size_t O_WPG = O_WD + (size_t)2 * 1024 * 2816 * 2;
constexpr size_t O_WPP = O_WPG + (size_t)2 * 1024 * 1024 * 2;
constexpr size_t O_WIN = O_WPP + (size_t)2 * 1024 * 256 * 2;
constexpr size_t O_WGR = O_WIN + (size_t)3072 * 1024 * 2;
constexpr size_t O_WO = O_WGR + 16 * 1024 * 2;
constexpr size_t O_GR = O_WO + (size_t)1024 * 1024 * 2;
constexpr size_t O_SSQ = O_GR + (size_t)M * 16 * 4;
constexpr size_t O_DEC = O_SSQ + (size_t)7 * M * 4;
constexpr size_t O_BAR = O_DEC + (size_t)NITEM * 128 * 4;
constexpr size_t BAR_BYTES = 32768;
constexpr size_t O_HBA = O_BAR + BAR_BYTES;
constexpr size_t O_HBB = O_HBA + SZ_HB;
constexpr size_t O_BIG = O_HBB + SZ_HB;
constexpr size_t SZ_PB = (size_t)M * PLE * 2;
constexpr size_t O_PB1 = O_BIG;
constexpr size_t O_PP = O_BIG + SZ_PB;
constexpr size_t O_ACT = O_PP + SZ_HB;
constexpr size_t O_DM = O_ACT;
constexpr size_t O_PB0 = O_HBB;
constexpr size_t O_Q = O_HBB;
constexpr size_t O_K = O_HBB + (size_t)M * 512 * 2;
constexpr size_t O_OG = O_HBA;
constexpr size_t O_G = O_BIG + SZ_PB;
constexpr size_t O_VT = O_G + SZ_HB;
constexpr size_t O_KVT = O_VT + (size_t)1024 * MPAD * 2;
constexpr size_t WS_END_A = O_ACT + (size_t)M * DFF * 2;
constexpr size_t WS_END_B = O_KVT + (size_t)NITEM * 256 * 128 * 2;
constexpr size_t WS_NEED = WS_END_A > WS_END_B ? WS_END_A : WS_END_B;

constexpr size_t OUT_Y = 0;
constexpr size_t OUT_PSP = (size_t)M * D;
constexpr size_t OUT_PSS = OUT_PSP + 4 * 15 * 1024;
constexpr size_t OUT_GSP = OUT_PSS + 16 * 15 * 1024;
constexpr size_t OUT_GSS = OUT_GSP + (size_t)16 * 128 * 256;

struct Params {
    const float* in[23];
    float* out;
    unsigned char* ws;
    int ph_lo, ph_hi;
};

__device__ __forceinline__ unsigned cvt_pk_bf16(float lo, float hi) { unsigned r; asm volatile("v_cvt_pk_bf16_f32 %0, %1, %2" : "=v"(r) : "v"(lo), "v"(hi)); return r; }
__device__ __forceinline__ float bf_lo(unsigned w) { return __uint_as_float(w << 16); }
__device__ __forceinline__ float bf_hi(unsigned w) { return __uint_as_float(w & 0xffff0000u); }
__device__ __forceinline__ float bf1(bf16_t b) { return __uint_as_float(((unsigned)b) << 16); }
__device__ __forceinline__ float sigmoidf_(float x) { return __builtin_amdgcn_rcpf(1.0f + __expf(-x)); }
__device__ __forceinline__ float siluf_(float x) { return x * sigmoidf_(x); }
__device__ __forceinline__ float rinv_of(float ssq) { return rsqrtf(ssq * (1.0f / 1024.0f) + EPS); }


#define XB_TMO      128
#define XB_XCNT(j)  (256  + 64 * (j))
#define XB_XSUB(j)  (1280 + 64 * (j))
#define XB_XGEN(j)  (2304 + 64 * (j))
#define XB_TOP      3328
#define XB_TOPGEN   3392
#define XB_SPIN_CAP (1u << 18)
__device__ __forceinline__ unsigned xb_ld(unsigned* p)              { return __hip_atomic_load(p, __ATOMIC_RELAXED, __HIP_MEMORY_SCOPE_AGENT); }
__device__ __forceinline__ unsigned xb_add(unsigned* p, unsigned v) { return __hip_atomic_fetch_add(p, v, __ATOMIC_RELAXED, __HIP_MEMORY_SCOPE_AGENT); }
__device__ __forceinline__ unsigned xb_xcc_id() { return (unsigned)__builtin_amdgcn_s_getreg((3 << 11) | 20) & 0xFu; }
#define XB_SPIN(cond, bar) do { unsigned _sp = 0; while (cond) { __builtin_amdgcn_s_sleep(1); \
    if ((++_sp & 255u) == 0u) { if (xb_ld(&(bar)[XB_TMO])) break; if (_sp > XB_SPIN_CAP) { atomicAdd(&(bar)[XB_TMO], 1u); break; } } } } while (0)
struct XcdBarrier { unsigned* bar; unsigned x; volatile LAS unsigned* st; };
__device__ __forceinline__ XcdBarrier xcd_barrier_post(unsigned* bar, volatile LAS unsigned* st) {
    XcdBarrier b; b.bar = bar; b.x = xb_xcc_id(); b.st = st;
    if (threadIdx.x == 0) (void)xb_add(&bar[XB_XCNT(b.x)], 1u);
    return b;
}
__device__ __forceinline__ void xcd_barrier_complete(unsigned* bar, unsigned x, unsigned& nloc, unsigned& nx) {
    const unsigned G = gridDim.x * gridDim.y * gridDim.z;
    unsigned sum, cnt, mine, sp = 0u;
    for (;;) {
        sum = 0u; cnt = 0u; mine = 0u;
#pragma unroll
        for (unsigned j = 0; j < 16; ++j) { const unsigned c = xb_ld(&bar[XB_XCNT(j)]); sum += c; cnt += (c > 0u) ? 1u : 0u; mine = (j == x) ? c : mine; }
        if (sum == G) break;
        __builtin_amdgcn_s_sleep(1);
        if ((++sp & 255u) == 0u) { if (xb_ld(&bar[XB_TMO])) break; if (sp > XB_SPIN_CAP) { atomicAdd(&bar[XB_TMO], 1u); break; } }
    }
    nloc = mine > 0u ? mine : 1u; nx = cnt > 0u ? cnt : 1u;
}
__device__ __forceinline__ void xcd_barrier(const XcdBarrier& b) {
    asm volatile("s_waitcnt vmcnt(0)" ::: "memory");
    __syncthreads();
    if (threadIdx.x == 0) {
        unsigned* bar = b.bar;
        __builtin_amdgcn_s_waitcnt(0);
        unsigned nloc = b.st[0], nx = b.st[1];
        if (nloc == 0u) { xcd_barrier_complete(bar, b.x, nloc, nx); b.st[0] = nloc; b.st[1] = nx; }
        const unsigned old = xb_add(&bar[XB_XSUB(b.x)], 1u);
        const unsigned gen = old / nloc;
        if (old + 1u == (gen + 1u) * nloc) {
            __builtin_amdgcn_fence(__ATOMIC_RELEASE, "agent");
            asm volatile("s_waitcnt vmcnt(0)" ::: "memory");
            const unsigned og = xb_add(&bar[XB_TOP], 1u);
            const unsigned tg = og / nx;
            if (og + 1u == (tg + 1u) * nx) xb_add(&bar[XB_TOPGEN], 1u);
            else XB_SPIN(xb_ld(&bar[XB_TOPGEN]) == tg, bar);
            __builtin_amdgcn_fence(__ATOMIC_ACQUIRE, "agent");
            xb_add(&bar[XB_XGEN(b.x)], 1u);
            asm volatile("s_waitcnt vmcnt(0)" ::: "memory");
        } else {
            XB_SPIN(xb_ld(&bar[XB_XGEN(b.x)]) == gen, bar);
            __builtin_amdgcn_fence(__ATOMIC_ACQUIRE, "agent");
            asm volatile("s_waitcnt vmcnt(0)" ::: "memory");
        }
    }
    __syncthreads();
}

namespace pg8 {
constexpr int BM = 256, BK = 64, HALF = 128, HTB = HALF * BK * 2, NXCD = 8, WGM = 4;
__device__ __forceinline__ int lds_byte(int r, int c) { const int st = (r >> 4) * 2 + (c >> 5), rr = r & 15, cc = c & 31, ob = rr * 64 + cc * 2; return st * 1024 + (ob ^ (((ob >> 9) & 1) << 5)); }
__device__ __forceinline__ void stage_rc(int b, int& R, int& C) { const int st = b / 1024, sb = b % 1024, swz = sb ^ (((sb >> 9) & 1) << 5); R = (st >> 1) * 16 + swz / 64; C = (st & 1) * 32 + (swz % 64) / 2; }
__device__ __forceinline__ int perm32(int rho) { const int n = rho >> 4, i = rho & 15; return 8 * (i >> 2) + 4 * n + (i & 3); }
struct Unit { int pm, pn; };
struct Gemm { const bf16_t* A; const bf16_t* Bt; int lda, ldb, K, a_pn_off; };
struct StaticOrder {
    int nM, nN, nwg, G, c;
    __device__ __forceinline__ void init(int nM_, int nN_, int G_, int c_) { nM = nM_; nN = nN_; nwg = nM * nN; G = G_; c = c_; }
    __device__ __forceinline__ bool next(int i, Unit& u) const {
        const long L = (long)i * G + c; if (L >= nwg) return false;
        int wgid = (int)L; { const int q = nwg / NXCD, r = nwg % NXCD, xcd = wgid % NXCD, off = wgid / NXCD; wgid = (xcd < r ? xcd * (q + 1) : r * (q + 1) + (xcd - r) * q) + off; }
        const int nig = WGM * nN, gid = wgid / nig, fm = gid * WGM, gsz = (nM - fm) < WGM ? (nM - fm) : WGM;
        u.pm = fm + ((wgid % nig) % gsz); u.pn = (wgid % nig) / gsz; return true;
    }
};

template <class Epi>
__device__ __forceinline__ void gemm_phase(LAS unsigned char* lds, const Gemm g, const StaticOrder& S, const Epi& E) {
    int tid = threadIdx.x; asm volatile("" : "+v"(tid));
    const int wid = __builtin_amdgcn_readfirstlane(tid >> 6), lane = tid & 63, wr = wid >> 2, wc = wid & 3, fr = lane & 15, fq = lane >> 4;
    int K = g.K; asm volatile("" : "+s"(K));
    const int nt = K / BK;
    unsigned voffA[2], voffB[2];
#pragma unroll
    for (int i = 0; i < 2; ++i) { int R, C; stage_rc(tid * 16 + i * 8192, R, C); const int Rb = (R & ~31) + perm32(R & 31);
        voffA[i] = (unsigned)(R * g.lda + C) * 2u; voffB[i] = (unsigned)(Rb * g.ldb + C) * 2u; }
    const size_t kstep = (size_t)(BK * 2);
    const size_t hstepA = (size_t)HALF * g.lda * 2, hstepB = (size_t)HALF * g.ldb * 2;
    const size_t tstepA = 2 * hstepA, tstepB = 2 * hstepB;
    const unsigned ldsw = (unsigned)wid * 1024u;
    const int aoff = lds_byte(wr * 64 + fr, fq * 8), boff = lds_byte(wc * 32 + fr, fq * 8);
#define PG8_SA(b, h) (((b) * 2 + (h)) * HTB)
#define PG8_SB(b, h) ((4 + (b) * 2 + (h)) * HTB)
#define PG8_STAGE(bufoff, gbase, voff) do { _Pragma("unroll") for (int _i = 0; _i < 2; ++_i) \
        __builtin_amdgcn_global_load_lds((const unsigned*)((const char*)(gbase) + (voff)[_i]), (LAS unsigned*)(lds + (bufoff) + ldsw + _i * 8192), 16, 0, 0); } while (0)
#define PG8_LDA(dst, b, h) do { _Pragma("unroll") for (int m = 0; m < 4; ++m) _Pragma("unroll") for (int k = 0; k < 2; ++k) dst[m][k] = *(const LAS bf16x8*)(lds + PG8_SA(b, h) + aoff + m * 2048 + k * 1024); } while (0)
#define PG8_LDB(dst, b, h) do { _Pragma("unroll") for (int n = 0; n < 2; ++n) _Pragma("unroll") for (int k = 0; k < 2; ++k) dst[n][k] = *(const LAS bf16x8*)(lds + PG8_SB(b, h) + boff + n * 2048 + k * 1024); } while (0)
#define PG8_MMA(ai, bj, At, Bt) do { __builtin_amdgcn_s_setprio(1); _Pragma("unroll") for (int m = 0; m < 4; ++m) _Pragma("unroll") for (int n = 0; n < 2; ++n) _Pragma("unroll") for (int k = 0; k < 2; ++k) \
        acc[ai][bj][m][n] = __builtin_amdgcn_mfma_f32_16x16x32_bf16(Bt[n][k], At[m][k], acc[ai][bj][m][n], 0, 0, 0); __builtin_amdgcn_s_setprio(0); } while (0)
#define PG8_WAIT_V(n) asm volatile("s_waitcnt vmcnt(" #n ")" ::: "memory")
#define PG8_WAIT_L(n) asm volatile("s_waitcnt lgkmcnt(" #n ")" ::: "memory")
#define PG8_BAR __builtin_amdgcn_s_barrier()
#define PG8_SCHED __builtin_amdgcn_sched_barrier(0)
    Unit cur, nxt; int ui = 0;
    if (!S.next(0, cur)) return;
    f32x4 acc[2][2][4][2];
#pragma unroll
    for (int a = 0; a < 2; ++a)
#pragma unroll
        for (int b = 0; b < 2; ++b)
#pragma unroll
            for (int m = 0; m < 4; ++m)
#pragma unroll
                for (int n = 0; n < 2; ++n) acc[a][b][m][n] = (f32x4){0.f, 0.f, 0.f, 0.f};
    bf16x8 At[4][2], B0[2][2], B1[2][2];
    const char* cA = (const char*)g.A + (size_t)cur.pm * tstepA + (size_t)cur.pn * g.a_pn_off * 2; const char* cB = (const char*)g.Bt + (size_t)cur.pn * tstepB;
    PG8_STAGE(PG8_SB(0, 0), cB, voffB); PG8_STAGE(PG8_SA(0, 0), cA, voffA); PG8_STAGE(PG8_SB(0, 1), cB + hstepB, voffB); PG8_STAGE(PG8_SA(0, 1), cA + hstepA, voffA);
    if (wr == 1) PG8_BAR;
    PG8_WAIT_V(4); PG8_BAR;
    PG8_STAGE(PG8_SB(1, 0), cB + kstep, voffB); PG8_STAGE(PG8_SA(1, 0), cA + kstep, voffA); PG8_STAGE(PG8_SB(1, 1), cB + hstepB + kstep, voffB);
    PG8_WAIT_V(6); PG8_BAR;
    for (;;) {
        const bool has_next = S.next(ui + 1, nxt);
        const char* nA = has_next ? (const char*)g.A + (size_t)nxt.pm * tstepA + (size_t)nxt.pn * g.a_pn_off * 2 : cA; const char* nB = has_next ? (const char*)g.Bt + (size_t)nxt.pn * tstepB : cB;
        for (int t = 0; t < nt; t += 2) {
            const bool last = (t == nt - 2);
            const char* a1 = cA + (size_t)(t + 1) * kstep;
            const char* a2 = last ? nA : cA + (size_t)(t + 2) * kstep; const char* b2 = last ? nB : cB + (size_t)(t + 2) * kstep;
            const char* a3 = a2 + kstep; const char* b3 = b2 + kstep;
            PG8_LDB(B0, 0, 0); PG8_SCHED; PG8_LDA(At, 0, 0); PG8_STAGE(PG8_SA(1, 1), a1 + hstepA, voffA);
            PG8_WAIT_L(8); PG8_BAR; PG8_WAIT_L(0); PG8_MMA(0, 0, At, B0); PG8_BAR; PG8_SCHED;
            PG8_LDB(B1, 0, 1); PG8_STAGE(PG8_SB(0, 0), b2, voffB);
            PG8_BAR; PG8_WAIT_L(0); PG8_MMA(0, 1, At, B1); PG8_BAR;
            PG8_LDA(At, 0, 1); PG8_STAGE(PG8_SA(0, 0), a2, voffA);
            PG8_BAR; PG8_WAIT_L(0); PG8_MMA(1, 0, At, B0); PG8_BAR; PG8_SCHED;
            PG8_STAGE(PG8_SB(0, 1), b2 + hstepB, voffB);
            PG8_WAIT_V(6); PG8_BAR; PG8_MMA(1, 1, At, B1); PG8_BAR;
            PG8_LDB(B0, 1, 0); PG8_SCHED; PG8_LDA(At, 1, 0); PG8_STAGE(PG8_SA(0, 1), a2 + hstepA, voffA);
            PG8_WAIT_L(8); PG8_BAR; PG8_WAIT_L(0); PG8_MMA(0, 0, At, B0); PG8_BAR; PG8_SCHED;
            PG8_LDB(B1, 1, 1); PG8_STAGE(PG8_SB(1, 0), b3, voffB);
            PG8_BAR; PG8_WAIT_L(0); PG8_MMA(0, 1, At, B1); PG8_BAR;
            PG8_LDA(At, 1, 1); PG8_STAGE(PG8_SA(1, 0), a3, voffA);
            PG8_BAR; PG8_WAIT_L(0); PG8_MMA(1, 0, At, B0); PG8_BAR; PG8_SCHED;
            PG8_STAGE(PG8_SB(1, 1), b3 + hstepB, voffB);
            PG8_WAIT_V(6); PG8_BAR; PG8_MMA(1, 1, At, B1); PG8_BAR;
        }
        E(acc, cur, wr, wc, fr, fq);
        if (!has_next) break;
#pragma unroll
        for (int a = 0; a < 2; ++a)
#pragma unroll
            for (int b = 0; b < 2; ++b)
#pragma unroll
                for (int m = 0; m < 4; ++m)
#pragma unroll
                    for (int n = 0; n < 2; ++n) acc[a][b][m][n] = (f32x4){0.f, 0.f, 0.f, 0.f};
        cur = nxt; cA = nA; cB = nB; ++ui;
    }
    PG8_WAIT_V(0);
    if (wr == 0) PG8_BAR;
    PG8_BAR;
#undef PG8_SA
#undef PG8_SB
#undef PG8_STAGE
#undef PG8_LDA
#undef PG8_LDB
#undef PG8_MMA
#undef PG8_WAIT_V
#undef PG8_WAIT_L
#undef PG8_BAR
#undef PG8_SCHED
}
}

typedef f32x4 AccT[2][2][4][2];
#define EPI_ROW(u, ai, m) ((u).pm * 256 + (ai) * 128 + wr * 64 + (m) * 16 + fr)
#define EPI_COL(u, bj) ((u).pn * 256 + (bj) * 128 + wc * 32 + 8 * fq)

__device__ __forceinline__ u32x4 pack8(const f32x4 a, const f32x4 b) { u32x4 w; w.x = cvt_pk_bf16(a[0], a[1]); w.y = cvt_pk_bf16(a[2], a[3]); w.z = cvt_pk_bf16(b[0], b[1]); w.w = cvt_pk_bf16(b[2], b[3]); return w; }
__device__ __forceinline__ float sq8(const f32x4 a, const f32x4 b) { return (a[0] * a[0] + a[1] * a[1]) + (a[2] * a[2] + a[3] * a[3]) + (b[0] * b[0] + b[1] * b[1]) + (b[2] * b[2] + b[3] * b[3]); }
__device__ __forceinline__ void ssq_commit(float s, float* ssq, int r, int fq) { s += __shfl_xor(s, 16); s += __shfl_xor(s, 32); if (fq == 0) atomicAdd(ssq + r, s); }

struct EpiPool {
    const float* xp; const float* xs; float* h; bf16_t* hb; const float* bias; const float* scale; float* ssq;
    static constexpr bool HAS_SSQ = true;
    __device__ __forceinline__ float apply8(int r, int c, const f32x4 a0, const f32x4 a1) const {
        const float* xrow = r < MP_ROWS ? xp + (size_t)r * D : xs + (size_t)(r - MP_ROWS) * D;
        const f32x4 v0 = *(const f32x4*)(xrow + c) + (a0 + *(const f32x4*)(bias + c)) * *(const f32x4*)(scale + c);
        const f32x4 v1 = *(const f32x4*)(xrow + c + 4) + (a1 + *(const f32x4*)(bias + c + 4)) * *(const f32x4*)(scale + c + 4);
        *(f32x4*)(h + (size_t)r * D + c) = v0; *(f32x4*)(h + (size_t)r * D + c + 4) = v1; *(u32x4*)(hb + (size_t)r * D + c) = pack8(v0, v1); return sq8(v0, v1); }
    __device__ __forceinline__ void operator()(const AccT& acc, const pg8::Unit& u, int wr, int wc, int fr, int fq) const {
        asm volatile("" : "+v"(fr), "+v"(fq), "+s"(wr), "+s"(wc));
#pragma unroll
        for (int ai = 0; ai < 2; ++ai)
#pragma unroll
            for (int mp = 0; mp < 2; ++mp) {
                f32x4 xv[2][2][2], bb[2][2], sc[2][2];
#pragma unroll
                for (int bj = 0; bj < 2; ++bj) { const int c = EPI_COL(u, bj); bb[bj][0] = *(const f32x4*)(bias + c); bb[bj][1] = *(const f32x4*)(bias + c + 4); sc[bj][0] = *(const f32x4*)(scale + c); sc[bj][1] = *(const f32x4*)(scale + c + 4); }
#pragma unroll
                for (int mm = 0; mm < 2; ++mm) { const int r = EPI_ROW(u, ai, 2 * mp + mm); const float* xrow = r < MP_ROWS ? xp + (size_t)r * D : xs + (size_t)(r - MP_ROWS) * D;
#pragma unroll
                    for (int bj = 0; bj < 2; ++bj) { const int c = EPI_COL(u, bj); xv[mm][bj][0] = *(const f32x4*)(xrow + c); xv[mm][bj][1] = *(const f32x4*)(xrow + c + 4); } }
#pragma unroll
                for (int mm = 0; mm < 2; ++mm) { const int m = 2 * mp + mm, r = EPI_ROW(u, ai, m); float s = 0.f;
#pragma unroll
                    for (int bj = 0; bj < 2; ++bj) { const int c = EPI_COL(u, bj);
                        const f32x4 v0 = xv[mm][bj][0] + (acc[ai][bj][m][0] + bb[bj][0]) * sc[bj][0], v1 = xv[mm][bj][1] + (acc[ai][bj][m][1] + bb[bj][1]) * sc[bj][1];
                        *(f32x4*)(h + (size_t)r * D + c) = v0; *(f32x4*)(h + (size_t)r * D + c + 4) = v1;
                        *(u32x4*)(hb + (size_t)r * D + c) = pack8(v0, v1); s += sq8(v0, v1); }
                    ssq_commit(s, ssq, r, fq); }
                asm volatile("" ::: "memory"); }
    }
};
struct EpiRes {
    float* h; bf16_t* hb; float* ssq; float mul;
    static constexpr bool HAS_SSQ = true;
    __device__ __forceinline__ float apply8(int r, int c, const f32x4 a0, const f32x4 a1) const {
        float* hp = h + (size_t)r * D + c; const f32x4 v0 = *(const f32x4*)hp + a0 * mul, v1 = *(const f32x4*)(hp + 4) + a1 * mul;
        *(f32x4*)hp = v0; *(f32x4*)(hp + 4) = v1; *(u32x4*)(hb + (size_t)r * D + c) = pack8(v0, v1); return sq8(v0, v1); }
    __device__ __forceinline__ void operator()(const AccT& acc, const pg8::Unit& u, int wr, int wc, int fr, int fq) const {
        asm volatile("" : "+v"(fr), "+v"(fq), "+s"(wr), "+s"(wc));
#pragma unroll
        for (int ai = 0; ai < 2; ++ai) {
            f32x4 hv[4][2][2];
#pragma unroll
            for (int m = 0; m < 4; ++m)
#pragma unroll
                for (int bj = 0; bj < 2; ++bj) { const float* hp = h + (size_t)EPI_ROW(u, ai, m) * D + EPI_COL(u, bj); hv[m][bj][0] = *(const f32x4*)hp; hv[m][bj][1] = *(const f32x4*)(hp + 4); }
#pragma unroll
            for (int m = 0; m < 4; ++m) {
                const int r = EPI_ROW(u, ai, m); float s = 0.f;
#pragma unroll
                for (int bj = 0; bj < 2; ++bj) { const int c = EPI_COL(u, bj); float* hp = h + (size_t)r * D + c;
                    const f32x4 v0 = hv[m][bj][0] + acc[ai][bj][m][0] * mul, v1 = hv[m][bj][1] + acc[ai][bj][m][1] * mul;
                    *(f32x4*)hp = v0; *(f32x4*)(hp + 4) = v1;
                    *(u32x4*)(hb + (size_t)r * D + c) = pack8(v0, v1); s += sq8(v0, v1); }
                ssq_commit(s, ssq, r, fq); }
            asm volatile("" ::: "memory"); }
    }
};
struct EpiPle {
    float* h; bf16_t* hb; const bf16_t* pp; const float* ssq_in; float* ssq; float mul;
    static constexpr bool HAS_SSQ = true;
    __device__ __forceinline__ float apply8(int r, int c, const f32x4 a0_, const f32x4 a1_) const {
        const float ri = rinv_of(ssq_in[r]); float* hp = h + (size_t)r * D + c; const u32x4 pw = *(const u32x4*)(pp + (size_t)r * D + c);
        const f32x4 a0 = a0_ * ri, a1 = a1_ * ri; f32x4 v0 = *(const f32x4*)hp, v1 = *(const f32x4*)(hp + 4);
        if (mul == 0.f) { if (hb) *(u32x4*)(hb + (size_t)r * D + c) = pack8(v0, v1); return 0.f; }
        v0[0] += sigmoidf_(a0[0]) * bf_lo(pw.x); v0[1] += sigmoidf_(a0[1]) * bf_hi(pw.x); v0[2] += sigmoidf_(a0[2]) * bf_lo(pw.y); v0[3] += sigmoidf_(a0[3]) * bf_hi(pw.y);
        v1[0] += sigmoidf_(a1[0]) * bf_lo(pw.z); v1[1] += sigmoidf_(a1[1]) * bf_hi(pw.z); v1[2] += sigmoidf_(a1[2]) * bf_lo(pw.w); v1[3] += sigmoidf_(a1[3]) * bf_hi(pw.w);
        *(f32x4*)hp = v0; *(f32x4*)(hp + 4) = v1; if (hb) *(u32x4*)(hb + (size_t)r * D + c) = pack8(v0, v1); return sq8(v0, v1); }
    __device__ __forceinline__ void operator()(const AccT& acc, const pg8::Unit& u, int wr, int wc, int fr, int fq) const {
        asm volatile("" : "+v"(fr), "+v"(fq), "+s"(wr), "+s"(wc));
#pragma unroll
        for (int ai = 0; ai < 2; ++ai)
#pragma unroll
            for (int mp = 0; mp < 2; ++mp) {
                f32x4 hv[2][2][2]; u32x4 pw[2][2]; float rs[2];
#pragma unroll
                for (int mm = 0; mm < 2; ++mm) { const int r = EPI_ROW(u, ai, 2 * mp + mm); rs[mm] = ssq_in[r];
#pragma unroll
                    for (int bj = 0; bj < 2; ++bj) { const int c = EPI_COL(u, bj); const float* hp = h + (size_t)r * D + c; hv[mm][bj][0] = *(const f32x4*)hp; hv[mm][bj][1] = *(const f32x4*)(hp + 4); pw[mm][bj] = *(const u32x4*)(pp + (size_t)r * D + c); } }
#pragma unroll
                for (int mm = 0; mm < 2; ++mm) { const int m = 2 * mp + mm, r = EPI_ROW(u, ai, m); float s = 0.f; const float ri = rinv_of(rs[mm]);
#pragma unroll
                    for (int bj = 0; bj < 2; ++bj) { const int c = EPI_COL(u, bj); float* hp = h + (size_t)r * D + c; const u32x4 p4 = pw[mm][bj];
                        const f32x4 a0 = acc[ai][bj][m][0] * ri, a1 = acc[ai][bj][m][1] * ri; f32x4 v0 = hv[mm][bj][0], v1 = hv[mm][bj][1];
                        v0[0] += mul * sigmoidf_(a0[0]) * bf_lo(p4.x); v0[1] += mul * sigmoidf_(a0[1]) * bf_hi(p4.x); v0[2] += mul * sigmoidf_(a0[2]) * bf_lo(p4.y); v0[3] += mul * sigmoidf_(a0[3]) * bf_hi(p4.y);
                        v1[0] += mul * sigmoidf_(a1[0]) * bf_lo(p4.z); v1[1] += mul * sigmoidf_(a1[1]) * bf_hi(p4.z); v1[2] += mul * sigmoidf_(a1[2]) * bf_lo(p4.w); v1[3] += mul * sigmoidf_(a1[3]) * bf_hi(p4.w);
                        *(f32x4*)hp = v0; *(f32x4*)(hp + 4) = v1;
                        if (hb) *(u32x4*)(hb + (size_t)r * D + c) = pack8(v0, v1);
                        s += sq8(v0, v1); }
                    ssq_commit(s, ssq, r, fq); }
                asm volatile("" ::: "memory"); }
    }
};
struct EpiGU {
    bf16_t* act; const float* ssq_in;
    __device__ __forceinline__ void operator()(const AccT& acc, const pg8::Unit& u, int wr, int wc, int fr, int fq) const {
        asm volatile("" : "+v"(fr), "+v"(fq), "+s"(wr), "+s"(wc));
        float ris[2][4];
#pragma unroll
        for (int ai = 0; ai < 2; ++ai)
#pragma unroll
            for (int m = 0; m < 4; ++m) ris[ai][m] = ssq_in[EPI_ROW(u, ai, m)];
#pragma unroll
        for (int ai = 0; ai < 2; ++ai)
#pragma unroll
            for (int m = 0; m < 4; ++m) {
                const int r = EPI_ROW(u, ai, m); const float ri = rinv_of(ris[ai][m]);
                f32x4 o[2];
#pragma unroll
                for (int n = 0; n < 2; ++n) { const f32x4 gt = acc[ai][0][m][n] * ri, up = acc[ai][1][m][n] * ri;
#pragma unroll
                    for (int j = 0; j < 4; ++j) o[n][j] = siluf_(gt[j]) * up[j]; }
                *(u32x4*)(act + (size_t)r * DFF + u.pn * 128 + wc * 32 + 8 * fq) = pack8(o[0], o[1]); }
    }
};
struct EpiBf {
    bf16_t* O; int ldc;
    static constexpr bool HAS_SSQ = false; float* ssq;
    __device__ __forceinline__ float apply8(int r, int c, const f32x4 a0, const f32x4 a1) const { *(u32x4*)(O + (size_t)r * ldc + c) = pack8(a0, a1); return 0.f; }
    __device__ __forceinline__ void operator()(const AccT& acc, const pg8::Unit& u, int wr, int wc, int fr, int fq) const {
        asm volatile("" : "+v"(fr), "+v"(fq), "+s"(wr), "+s"(wc));
#pragma unroll
        for (int ai = 0; ai < 2; ++ai)
#pragma unroll
            for (int m = 0; m < 4; ++m) { const int r = EPI_ROW(u, ai, m);
#pragma unroll
                for (int bj = 0; bj < 2; ++bj) { const int c = EPI_COL(u, bj); *(u32x4*)(O + (size_t)r * ldc + c) = pack8(acc[ai][bj][m][0], acc[ai][bj][m][1]); } }
    }
};
struct EpiQKG {
    bf16_t* q; bf16_t* k; bf16_t* g; const float* ssq_in;
    static constexpr bool HAS_SSQ = false; float* ssq;
    __device__ __forceinline__ float apply8(int r, int c, const f32x4 a0, const f32x4 a1) const {
        bf16_t* base; int ldc, cc; float sc = 1.0f;
        if (c < 512) { base = q; ldc = KEYD; cc = c; sc = 0.08838834764831845f; } else if (c < 1024) { base = k; ldc = KEYD; cc = c - 512; } else { base = g; ldc = D; cc = c - 1024; }
        const float ri = rinv_of(ssq_in[r]) * sc; *(u32x4*)(base + (size_t)r * ldc + cc) = pack8(a0 * ri, a1 * ri); return 0.f; }
    __device__ __forceinline__ void operator()(const AccT& acc, const pg8::Unit& u, int wr, int wc, int fr, int fq) const {
        asm volatile("" : "+v"(fr), "+v"(fq), "+s"(wr), "+s"(wc));
        bf16_t* base; int ldc, ct; float sc = 1.0f;
        if (u.pn < 2) { base = q; ldc = KEYD; ct = u.pn; sc = 0.08838834764831845f; } else if (u.pn < 4) { base = k; ldc = KEYD; ct = u.pn - 2; } else { base = g; ldc = D; ct = u.pn - 4; }
        float ris[2][4];
#pragma unroll
        for (int ai = 0; ai < 2; ++ai)
#pragma unroll
            for (int m = 0; m < 4; ++m) ris[ai][m] = ssq_in[EPI_ROW(u, ai, m)];
#pragma unroll
        for (int ai = 0; ai < 2; ++ai)
#pragma unroll
            for (int m = 0; m < 4; ++m) { const int r = EPI_ROW(u, ai, m); const float ri = rinv_of(ris[ai][m]) * sc;
#pragma unroll
                for (int bj = 0; bj < 2; ++bj) { const int c = ct * 256 + bj * 128 + wc * 32 + 8 * fq;
                    *(u32x4*)(base + (size_t)r * ldc + c) = pack8(acc[ai][bj][m][0] * ri, acc[ai][bj][m][1] * ri); } }
    }
};
struct EpiVT {
    bf16_t* vT; const float* ssq_in;
    static constexpr bool HAS_SSQ = false; float* ssq;
    __device__ __forceinline__ float apply8(int r, int c, const f32x4 a0, const f32x4 a1) const {
        const float ri = rinv_of(ssq_in[r]); const u32x4 w = pack8(a0 * ri, a1 * ri); bf16_t* p = vT + (size_t)c * MPAD + r;
        p[0] = (bf16_t)(w.x & 0xffffu); p[MPAD] = (bf16_t)(w.x >> 16); p[2 * (size_t)MPAD] = (bf16_t)(w.y & 0xffffu); p[3 * (size_t)MPAD] = (bf16_t)(w.y >> 16);
        p[4 * (size_t)MPAD] = (bf16_t)(w.z & 0xffffu); p[5 * (size_t)MPAD] = (bf16_t)(w.z >> 16); p[6 * (size_t)MPAD] = (bf16_t)(w.w & 0xffffu); p[7 * (size_t)MPAD] = (bf16_t)(w.w >> 16); return 0.f; }
    __device__ __forceinline__ void operator()(const AccT& acc, const pg8::Unit& u, int wr, int wc, int fr, int fq) const {
        asm volatile("" : "+v"(fr), "+v"(fq), "+s"(wr), "+s"(wc));
        f32x4 rs[2][2];
#pragma unroll
        for (int bj = 0; bj < 2; ++bj) { const int c = EPI_COL(u, bj); const f32x4 s0 = *(const f32x4*)(ssq_in + c), s1 = *(const f32x4*)(ssq_in + c + 4);
#pragma unroll
            for (int j = 0; j < 4; ++j) { rs[bj][0][j] = rinv_of(s0[j]); rs[bj][1][j] = rinv_of(s1[j]); } }
#pragma unroll
        for (int ai = 0; ai < 2; ++ai)
#pragma unroll
            for (int m = 0; m < 4; ++m) { const int r = EPI_ROW(u, ai, m);
#pragma unroll
                for (int bj = 0; bj < 2; ++bj) { const int c = EPI_COL(u, bj);
                    *(u32x4*)(vT + (size_t)r * MPAD + c) = pack8(acc[ai][bj][m][0] * rs[bj][0], acc[ai][bj][m][1] * rs[bj][1]); } }
    }
};


template <class Epi>
__device__ __forceinline__ void small_gemm(unsigned char* lds, const bf16_t* A, int lda, const bf16_t* Bt, int ldb, int K, int ncol_tiles, int a_grp_off, const Epi& E, int first = -1, int stride = 0) {
    int tid = threadIdx.x; asm volatile("" : "+v"(tid));
    const int wid = tid >> 6, lane = tid & 63, fr = lane & 15, fq = lane >> 4;
    float* part = (float*)lds;
    const int kw = K >> 3, ksteps = kw >> 5;
    if (first < 0) { first = blockIdx.x; stride = gridDim.x; }
    for (int tile = first; tile < 8 * ncol_tiles; tile += stride) {
        const int rt = tile & 7, ct = tile >> 3, r0 = MP_ROWS + 32 * rt, c0 = 32 * ct;
        const bf16_t* ap = A + (size_t)(r0 + fr) * lda + (c0 >> 8) * a_grp_off + wid * kw + 8 * fq;
        const bf16_t* bp = Bt + (size_t)(c0 + fr) * ldb + wid * kw + 8 * fq;
        f32x4 acc[2][2];
#pragma unroll
        for (int i = 0; i < 2; ++i)
#pragma unroll
            for (int j = 0; j < 2; ++j) acc[i][j] = (f32x4){0.f, 0.f, 0.f, 0.f};
        for (int s0 = 0; s0 < ksteps; s0 += 4) {
            bf16x8 a0[4], a1[4], b0[4], b1[4];
#pragma unroll
            for (int j = 0; j < 4; ++j) if (s0 + j < ksteps) { const int s = s0 + j;
                a0[j] = *(const bf16x8*)(ap + 32 * s); a1[j] = *(const bf16x8*)(ap + (size_t)16 * lda + 32 * s);
                b0[j] = *(const bf16x8*)(bp + 32 * s); b1[j] = *(const bf16x8*)(bp + (size_t)16 * ldb + 32 * s); }
#pragma unroll
            for (int j = 0; j < 4; ++j) if (s0 + j < ksteps) {
                acc[0][0] = __builtin_amdgcn_mfma_f32_16x16x32_bf16(b0[j], a0[j], acc[0][0], 0, 0, 0); acc[0][1] = __builtin_amdgcn_mfma_f32_16x16x32_bf16(b1[j], a0[j], acc[0][1], 0, 0, 0);
                acc[1][0] = __builtin_amdgcn_mfma_f32_16x16x32_bf16(b0[j], a1[j], acc[1][0], 0, 0, 0); acc[1][1] = __builtin_amdgcn_mfma_f32_16x16x32_bf16(b1[j], a1[j], acc[1][1], 0, 0, 0); } }
#pragma unroll
        for (int i = 0; i < 2; ++i)
#pragma unroll
            for (int j = 0; j < 2; ++j) *(f32x4*)(part + (wid * 32 + 16 * i + fr) * 36 + 16 * j + 4 * fq) = acc[i][j];
        __syncthreads();
        if (tid < 128) { const int row = tid >> 2, oct = tid & 3; f32x4 v0 = (f32x4){0.f, 0.f, 0.f, 0.f}, v1 = v0;
#pragma unroll
            for (int w = 0; w < 8; ++w) { v0 += *(const f32x4*)(part + (w * 32 + row) * 36 + 8 * oct); v1 += *(const f32x4*)(part + (w * 32 + row) * 36 + 8 * oct + 4); }
            float sq = E.apply8(r0 + row, c0 + 8 * oct, v0, v1);
            if (Epi::HAS_SSQ) { sq += __shfl_xor(sq, 1); sq += __shfl_xor(sq, 2); if (oct == 0) atomicAdd(E.ssq + r0 + row, sq); } }
        __syncthreads();
    }
}

__device__ __forceinline__ void transpose_tile(const float* src, int ldsrc, int k0, int n0, bf16_t* dst, int ldd, const float* gain, int rowmode, float* T) {
    const int tid = threadIdx.x;
    { const int kk = tid >> 4, n4 = (tid & 15) * 4; const float* gp = gain ? gain : src;
        const f32x4 v0 = *(const f32x4*)(src + (size_t)(k0 + kk) * ldsrc + n0 + n4), v1 = *(const f32x4*)(src + (size_t)(k0 + kk + 32) * ldsrc + n0 + n4);
        float g0 = gp[k0 + kk], g1 = gp[k0 + kk + 32]; if (!gain) { g0 = 1.0f; g1 = 1.0f; }
#pragma unroll
        for (int j = 0; j < 4; ++j) { T[(n4 + j) * 65 + kk] = v0[j] * g0; T[(n4 + j) * 65 + kk + 32] = v1[j] * g1; } }
    __syncthreads();
    { const int n = tid >> 3, k8 = (tid & 7) * 8; const float* tp = T + n * 65 + k8; u32x4 w;
        w.x = cvt_pk_bf16(tp[0], tp[1]); w.y = cvt_pk_bf16(tp[2], tp[3]); w.z = cvt_pk_bf16(tp[4], tp[5]); w.w = cvt_pk_bf16(tp[6], tp[7]);
        const int nn = n0 + n; int row;
        if (rowmode == 1) row = (nn >> 7) * 256 + (nn & 127);
        else if (rowmode == 2) row = (nn >> 7) * 256 + 128 + (nn & 127);
        else if (rowmode == 3) row = nn < 1024 ? nn : (nn < 2048 ? nn + 1024 : nn - 1024);
        else row = nn;
        *(u32x4*)(dst + (size_t)row * ldd + k0 + k8) = w; }
    __syncthreads();
}

__device__ __forceinline__ void weight_tile(const Params& P, int t, float* T) {
    unsigned char* ws = P.ws;
    {
        int j = t; const float* src; int ldsrc, nkt, nnt; bf16_t* dst; int ldd; const float* gain = nullptr; int rowmode = 0;
        if (j < 64) { const int gi = j >> 4; j &= 15; src = P.in[10] + (size_t)gi * 65536; ldsrc = 256; nkt = 4; nnt = 4; dst = (bf16_t*)(ws + O_WP) + (size_t)gi * 65536; ldd = 256; }
        else if ((j -= 64) < 2816) { const int q = j / 704; j %= 704; const int layer = q >> 1, up = q & 1; src = P.in[up ? 19 : 18] + (size_t)layer * 1024 * 2816; ldsrc = 2816; nkt = 16; nnt = 44;
            dst = (bf16_t*)(ws + O_WGU) + (size_t)layer * 5632 * 1024; ldd = 1024; gain = P.in[7] + layer * 1024; rowmode = 1 + up; }
        else if ((j -= 2816) < 1408) { const int layer = j / 704; j %= 704; src = P.in[20] + (size_t)layer * 2816 * 1024; ldsrc = 1024; nkt = 44; nnt = 16; dst = (bf16_t*)(ws + O_WD) + (size_t)layer * 1024 * 2816; ldd = 2816; }
        else if ((j -= 1408) < 512) { const int layer = j >> 8; j &= 255; src = P.in[22] + (size_t)layer * 1024 * 1024; ldsrc = 1024; nkt = 16; nnt = 16; dst = (bf16_t*)(ws + O_WPG) + (size_t)layer * 1024 * 1024; ldd = 1024; gain = P.in[8] + layer * 1024; }
        else if ((j -= 512) < 128) { const int layer = j >> 6; j &= 63; src = P.in[21] + (size_t)layer * 256 * 1024; ldsrc = 1024; nkt = 4; nnt = 16; dst = (bf16_t*)(ws + O_WPP) + (size_t)layer * 1024 * 256; ldd = 256; }
        else if ((j -= 128) < 768) { src = P.in[13]; ldsrc = GIN; nkt = 16; nnt = 48; dst = (bf16_t*)(ws + O_WIN); ldd = 1024; gain = P.in[6] + 1024; rowmode = 3; }
        else { j -= 768; src = P.in[17]; ldsrc = 1024; nkt = 16; nnt = 16; dst = (bf16_t*)(ws + O_WO); ldd = 1024; }
        const int kt = j / nnt, ntile = j % nnt; (void)nkt;
        transpose_tile(src, ldsrc, kt * 64, ntile * 64, dst, ldd, gain, rowmode, T);
    }
}
constexpr int N_EARLY = 3264, N_DEFER = 2688;
__device__ __forceinline__ int early_tile(int k) { if (k < 1472) return k; k -= 1472; if (k < 704) return 2880 + k; k -= 704; if (k < 256) return 4288 + k; k -= 256; if (k < 64) return 4800 + k; k -= 64; return 4928 + k; }
__device__ __forceinline__ int defer_tile(int k) { if (k < 1408) return 1472 + k; k -= 1408; if (k < 704) return 3584 + k; k -= 704; if (k < 256) return 4544 + k; k -= 256; if (k < 64) return 4864 + k; k -= 64; return 5696 + k; }
__device__ __forceinline__ void prep_weights(const Params& P, float* T) {
    unsigned char* ws = P.ws;
    if (gridDim.x == 256) {
        if (blockIdx.x < 16) { for (int k = N_EARLY - 128 + blockIdx.x; k < N_EARLY; k += 16) weight_tile(P, early_tile(k), T); }
        else { for (int k = blockIdx.x - 16; k < N_EARLY - 128; k += 240) weight_tile(P, early_tile(k), T); }
    } else
        for (int k = blockIdx.x; k < N_EARLY; k += gridDim.x) weight_tile(P, early_tile(k), T);
    if (gridDim.x != 256) for (int k = blockIdx.x; k < N_DEFER; k += gridDim.x) weight_tile(P, defer_tile(k), T);
    for (int i = blockIdx.x * NT + threadIdx.x; i < 16 * 1024; i += gridDim.x * NT) { const int n = i >> 10, k = i & 1023;
        const float v = P.in[13][(size_t)k * GIN + 3072 + n] * P.in[6][1024 + k]; ((bf16_t*)(ws + O_WGR))[i] = (bf16_t)(cvt_pk_bf16(v, 0.f) & 0xffffu); }
    for (int i = blockIdx.x * NT + threadIdx.x; i < 6 * M; i += gridDim.x * NT) ((float*)(ws + O_SSQ))[i] = 0.f;
}

__device__ __forceinline__ void convert_p(const Params& P, int layer, bf16_t* dst) {
    const f32x4* pp = (const f32x4*)(P.in[4] + (size_t)layer * MP_ROWS * PLE); const f32x4* ps = (const f32x4*)(P.in[5] + (size_t)layer * MS_ROWS * PLE);
    constexpr int n4 = M * PLE / 4, np4 = MP_ROWS * PLE / 4;
    const int stride = gridDim.x * NT;
    for (int i0 = blockIdx.x * NT + threadIdx.x; i0 < n4; i0 += 8 * stride) {
        f32x4 v[8];
#pragma unroll
        for (int j = 0; j < 8; ++j) { int i = i0 + j * stride; i = i < n4 ? i : n4 - 1; const f32x4* src = i < np4 ? pp + i : ps + (i - np4); v[j] = *src; }
#pragma unroll
        for (int j = 0; j < 8; ++j) { const int i = i0 + j * stride; if (i < n4) { u32x2 w; w.x = cvt_pk_bf16(v[j][0], v[j][1]); w.y = cvt_pk_bf16(v[j][2], v[j][3]); ((u32x2*)dst)[i] = w; } }
    }
}

template <int W> __device__ __forceinline__ void pool_diffs_w(const Params& P, float* lf) {
    const int tid = threadIdx.x, wid = tid >> 6, lane = tid & 63;
    bf16_t* Dm = (bf16_t*)(P.ws + O_DM);
    float* wsum = lf;
    float* rinv = lf + 128;
    for (int it = blockIdx.x; it < 256 + 16; it += gridDim.x) {
        const bool smp = it >= 256; const int s = smp ? it - 256 : it >> 6, t0 = smp ? 0 : (it & 63) * 64, ngrp = smp ? 2 : 5;
        const int ch = tid * 2; constexpr float iw = 1.0f / (float)W; const f32x2 gn = *(const f32x2*)(P.in[6] + ch);
        float r0[16], r1[16], run0 = 0.f, run1 = 0.f;
#pragma unroll
        for (int i = 0; i < 16; ++i) { r0[i] = 0.f; r1[i] = 0.f; }
        f32x2 xv[16], xn[16];
#define POOL_LOAD(dst, g_) do { _Pragma("unroll") for (int i = 0; i < 16; ++i) { const int rel = (g_) * 16 + i - 16, t = t0 + rel; \
                const float* src_ = smp ? (rel >= 0 ? P.in[1] + (size_t)(s * 16 + rel) * D : P.in[2] + (size_t)(s * 15 + (rel + 15 > 0 ? rel + 15 : 0)) * D) : P.in[0] + (size_t)(s * SEQ + (t > 0 ? t : 0)) * D; \
                f32x2 v = *(const f32x2*)(src_ + ch);                       \
                const bool ok_ = smp ? (rel >= -15) : (t >= 0); if (!ok_) v = (f32x2){0.f, 0.f}; \
                dst[i] = v; } } while (0)
        POOL_LOAD(xv, 0);
        for (int grp = 0; grp < ngrp; ++grp) {
            if (grp + 1 < ngrp) POOL_LOAD(xn, grp + 1);
            float q8[8], q4[4], q2[2], q1;
#pragma unroll
            for (int j = 0; j < 8; ++j) { const float e = xv[2 * j].x * xv[2 * j].x + xv[2 * j].y * xv[2 * j].y, o = xv[2 * j + 1].x * xv[2 * j + 1].x + xv[2 * j + 1].y * xv[2 * j + 1].y;
                const bool hi = lane & 1; q8[j] = (hi ? o : e) + __shfl_xor(hi ? e : o, 1); }
#pragma unroll
            for (int j = 0; j < 4; ++j) { const bool hi = lane & 2; q4[j] = (hi ? q8[2 * j + 1] : q8[2 * j]) + __shfl_xor(hi ? q8[2 * j] : q8[2 * j + 1], 2); }
#pragma unroll
            for (int j = 0; j < 2; ++j) { const bool hi = lane & 4; q2[j] = (hi ? q4[2 * j + 1] : q4[2 * j]) + __shfl_xor(hi ? q4[2 * j] : q4[2 * j + 1], 4); }
            { const bool hi = lane & 8; q1 = (hi ? q2[1] : q2[0]) + __shfl_xor(hi ? q2[0] : q2[1], 8); }
            q1 += __shfl_xor(q1, 16); q1 += __shfl_xor(q1, 32);
            if (lane < 16) wsum[wid * 16 + lane] = q1;
            __syncthreads();
            if (tid < 16) { float tot = 0.f;
#pragma unroll
                for (int w8 = 0; w8 < 8; ++w8) tot += wsum[w8 * 16 + tid];
                rinv[tid] = rinv_of(tot); }
            __syncthreads();
#pragma unroll
            for (int i = 0; i < 16; ++i) { const int rel = grp * 16 + i - 16, t = t0 + rel;
                float a0, a1;
                if (smp && rel < 0) { a0 = xv[i].x; a1 = xv[i].y; } else { const float ri = rinv[i]; a0 = xv[i].x * ri * gn.x; a1 = xv[i].y * ri * gn.y; }
                run0 += a0 - r0[(i - W) & 15]; run1 += a1 - r1[(i - W) & 15];
                r0[i] = a0; r1[i] = a1;
                if (rel >= 0) {
                    const float s0 = run0, s1 = run1;
                    const float ic = (smp || t + 1 >= W) ? iw : 1.0f / (float)(t + 1);
                    const float d0 = s0 * ic - a0, d1 = s1 * ic - a1;
                    const size_t grow = smp ? (size_t)MP_ROWS + s * 16 + rel : (size_t)s * SEQ + t;
                    *(unsigned*)(Dm + grow * D + ch) = cvt_pk_bf16(d0, d1);
                    if (smp) { if (rel >= 1) *(f32x2*)(P.out + OUT_PSS + (size_t)(s * 15 + rel - 1) * D + ch) = (f32x2){a0, a1}; }
                    else if (t >= SEQ - 15) *(f32x2*)(P.out + OUT_PSP + (size_t)(s * 15 + t - (SEQ - 15)) * D + ch) = (f32x2){a0, a1};
                } }
#pragma unroll
            for (int i = 0; i < 16; ++i) xv[i] = xn[i];
        }
#undef POOL_LOAD
        __syncthreads();
    }
}
__device__ __forceinline__ void pool_diffs(const Params& P, float* lf) {
    const int g = __builtin_amdgcn_readfirstlane(threadIdx.x >> 7);
    if (g == 0) pool_diffs_w<2>(P, lf); else if (g == 1) pool_diffs_w<4>(P, lf); else if (g == 2) pool_diffs_w<8>(P, lf); else pool_diffs_w<16>(P, lf);
}

__device__ __forceinline__ void gr_pass(const bf16_t* hb, const bf16_t* WgrT, const float* ssq_in, float* gr) {
    const int lane = threadIdx.x & 63, wid = threadIdx.x >> 6, fr = lane & 15, fq = lane >> 4;
    for (int gidx = blockIdx.x * 8 + wid; gidx < M / 16; gidx += gridDim.x * 8) {
        const int r0 = gidx * 16; f32x4 acc = (f32x4){0.f, 0.f, 0.f, 0.f};
        const bf16_t* ap = hb + (size_t)(r0 + fr) * D + 8 * fq; const bf16_t* bp = WgrT + (size_t)fr * D + 8 * fq;
#pragma unroll 8
        for (int s = 0; s < 32; ++s) { const bf16x8 a = *(const bf16x8*)(ap + 32 * s), b = *(const bf16x8*)(bp + 32 * s); acc = __builtin_amdgcn_mfma_f32_16x16x32_bf16(a, b, acc, 0, 0, 0); }
#pragma unroll
        for (int j = 0; j < 4; ++j) { const int r = r0 + 4 * fq + j; gr[(size_t)r * 16 + fr] = acc[j] * rinv_of(ssq_in[r]); }
    }
}

struct Item { int row0, L, h, j; };
__device__ __forceinline__ Item decode_item(int it) { Item I; if (it < 1024) { const int b = it >> 8; I.h = (it >> 6) & 3; I.row0 = b * SEQ + (it & 63) * 64; I.L = 64; } else { const int j = it - 1024; I.h = j & 3; I.row0 = MP_ROWS + (j >> 2) * 16; I.L = 16; } I.j = it; return I; }

constexpr int L_GRS = 0;
constexpr int L_BSH = 4096;
constexpr int L_QT = 36864;
constexpr int L_KT = 38912;
constexpr int L_QD = 38912;
constexpr int L_KIN = 56320;
constexpr int L_PSH = 73728;
constexpr int L_SSQ = 82944;

__device__ __forceinline__ void compute_b(const Params& P, const Item& I, unsigned char* lds) {
    const int tid = threadIdx.x; float* grs = (float*)(lds + L_GRS); float* bsh = (float*)(lds + L_BSH); float* qt = (float*)(lds + L_QT);
    const float* gr = (const float*)(P.ws + O_GR);
    if (tid < 256) { const int t = tid >> 2, tc = t < I.L ? t : I.L - 1; f32x4 v = *(const f32x4*)(gr + (size_t)(I.row0 + tc) * 16 + (tid & 3) * 4); if (t >= I.L) v = (f32x4){0.f, 0.f, 0.f, 0.f}; *(f32x4*)(grs + tid * 4) = v; }
    const int dk = tid & 127, tq = tid >> 7;
    float wc[16];
#pragma unroll
    for (int r = 0; r < 16; ++r) wc[r] = P.in[14][r * KEYD + I.h * DK + dk];
    const float bias = P.in[15][I.h * DK + dk];
    __syncthreads();
    float bl[16]; float run = 0.f;
#pragma unroll
    for (int i = 0; i < 16; ++i) { const int t = tq * 16 + i; float a = bias;
#pragma unroll
        for (int r = 0; r < 16; ++r) a += grs[t * 16 + r] * wc[r];
        const float ls = fminf(a, 0.f) - __logf(1.0f + __expf(-fabsf(a)));
        run += (t < I.L) ? ls * (1.0f / 16.0f) : 0.f; bl[i] = run; }
    qt[tq * 128 + dk] = run;
    __syncthreads();
    float off = 0.f;
#pragma unroll
    for (int q = 0; q < 3; ++q) if (q < tq) off += qt[q * 128 + dk];
#pragma unroll
    for (int i = 0; i < 16; ++i) bsh[(tq * 16 + i) * 128 + dk] = bl[i] + off;
    __syncthreads();
}

__device__ __forceinline__ void gla_g1(const Params& P, unsigned char* lds) {
    const int tid = threadIdx.x, wid = tid >> 6, lane = tid & 63, fr = lane & 15, fq = lane >> 4;
    const bf16_t* kg = (const bf16_t*)(P.ws + O_K); const bf16_t* vT = (const bf16_t*)(P.ws + O_VT);
    bf16_t* KVT = (bf16_t*)(P.ws + O_KVT); float* dec = (float*)(P.ws + O_DEC);
    const float* bsh = (const float*)(lds + L_BSH); bf16_t* kT = (bf16_t*)(lds + L_KT);
    for (int it = blockIdx.x; it < NITEM; it += gridDim.x) {
        const Item I = decode_item(it);
        compute_b(P, I, lds);
        { const int dk = tid & 127, tq = tid >> 7; const float blast = bsh[63 * 128 + dk]; float ke[16];
            bf16_t kraw[16];
#pragma unroll
            for (int i = 0; i < 16; ++i) { const int t = tq * 16 + i, tc = t < I.L ? t : I.L - 1; kraw[i] = kg[(size_t)(I.row0 + tc) * KEYD + I.h * DK + dk]; }
#pragma unroll
            for (int i = 0; i < 16; ++i) { const int t = tq * 16 + i; const float kv = bf1(kraw[i]) * __expf(blast - bsh[t * 128 + dk]); ke[i] = t < I.L ? kv : 0.f; }
            u32x4 w0, w1; w0.x = cvt_pk_bf16(ke[0], ke[1]); w0.y = cvt_pk_bf16(ke[2], ke[3]); w0.z = cvt_pk_bf16(ke[4], ke[5]); w0.w = cvt_pk_bf16(ke[6], ke[7]);
            w1.x = cvt_pk_bf16(ke[8], ke[9]); w1.y = cvt_pk_bf16(ke[10], ke[11]); w1.z = cvt_pk_bf16(ke[12], ke[13]); w1.w = cvt_pk_bf16(ke[14], ke[15]);
            *(u32x4*)(kT + dk * 72 + tq * 16) = w0; *(u32x4*)(kT + dk * 72 + tq * 16 + 8) = w1;
            if (tq == 0) dec[(size_t)it * 128 + dk] = __expf(blast); }
        __syncthreads();
        f32x4 acc[8][2];
#pragma unroll
        for (int mt = 0; mt < 8; ++mt) { acc[mt][0] = (f32x4){0.f, 0.f, 0.f, 0.f}; acc[mt][1] = (f32x4){0.f, 0.f, 0.f, 0.f}; }
#pragma unroll
        for (int s = 0; s < 2; ++s) { const int t8 = 32 * s + 8 * fq;
            if (32 * s < I.L) {
                bf16x8 bfr[2];
#pragma unroll
                for (int nt = 0; nt < 2; ++nt) { const int tc = t8 < I.L ? t8 : 0; bfr[nt] = *(const bf16x8*)(vT + (size_t)(I.h * DV + 32 * wid + 16 * nt + fr) * MPAD + I.row0 + tc); if (t8 >= I.L) bfr[nt] = (bf16x8){0, 0, 0, 0, 0, 0, 0, 0}; }
#pragma unroll
                for (int mt = 0; mt < 8; ++mt) { const bf16x8 a = *(const bf16x8*)(kT + (16 * mt + fr) * 72 + t8);
                    acc[mt][0] = __builtin_amdgcn_mfma_f32_16x16x32_bf16(a, bfr[0], acc[mt][0], 0, 0, 0); acc[mt][1] = __builtin_amdgcn_mfma_f32_16x16x32_bf16(a, bfr[1], acc[mt][1], 0, 0, 0); } } }
#pragma unroll
        for (int mt = 0; mt < 8; ++mt)
#pragma unroll
            for (int nt = 0; nt < 2; ++nt) { u32x2 w; w.x = cvt_pk_bf16(acc[mt][nt][0], acc[mt][nt][1]); w.y = cvt_pk_bf16(acc[mt][nt][2], acc[mt][nt][3]);
                *(u32x2*)(KVT + ((size_t)it * 256 + 32 * wid + 16 * nt + fr) * 128 + 16 * mt + 4 * fq) = w; }
        __syncthreads();
    }
}

__device__ __forceinline__ void gla_g2(const Params& P, unsigned char* lds) {
    const int tid = threadIdx.x; bf16_t* KVT = (bf16_t*)(P.ws + O_KVT); const float* dec = (const float*)(P.ws + O_DEC); float* tile = (float*)lds;
    const int dvl = tid >> 5, dk4 = (tid & 31) * 4, odk = tid >> 2, odv4 = (tid & 3) * 4;
    for (int u = blockIdx.x; u < 256; u += gridDim.x) {
        const int bh = u >> 4, dvb = u & 15, dv = dvb * 16 + dvl; f32x4 S = (f32x4){0.f, 0.f, 0.f, 0.f};
        for (int cb = 0; cb < 8; ++cb) {
            u32x2 kv[8]; f32x4 d[8];
#pragma unroll
            for (int j = 0; j < 8; ++j) { const int it = bh * 64 + cb * 8 + j; kv[j] = *(const u32x2*)(KVT + ((size_t)it * 256 + dv) * 128 + dk4); d[j] = *(const f32x4*)(dec + (size_t)it * 128 + dk4); }
#pragma unroll
            for (int j = 0; j < 8; ++j) { const int it = bh * 64 + cb * 8 + j; u32x2 w; w.x = cvt_pk_bf16(S[0], S[1]); w.y = cvt_pk_bf16(S[2], S[3]);
                *(u32x2*)(KVT + ((size_t)it * 256 + dv) * 128 + dk4) = w;
                S[0] = d[j][0] * S[0] + bf_lo(kv[j].x); S[1] = d[j][1] * S[1] + bf_hi(kv[j].x); S[2] = d[j][2] * S[2] + bf_lo(kv[j].y); S[3] = d[j][3] * S[3] + bf_hi(kv[j].y); }
        }
        __syncthreads();
#pragma unroll
        for (int i = 0; i < 4; ++i) tile[(dk4 + i) * 17 + dvl] = S[i];
        __syncthreads();
        { f32x4 o; o[0] = tile[odk * 17 + odv4]; o[1] = tile[odk * 17 + odv4 + 1]; o[2] = tile[odk * 17 + odv4 + 2]; o[3] = tile[odk * 17 + odv4 + 3];
            *(f32x4*)(P.out + OUT_GSP + ((size_t)bh * 128 + odk) * 256 + dvb * 16 + odv4) = o; }
    }
    for (int u = blockIdx.x; u < 1024; u += gridDim.x) {
        const int j = u >> 4, dvb = u & 15, it = 1024 + j, dv = dvb * 16 + dvl;
        __syncthreads();
        { const f32x4 v = *(const f32x4*)(P.in[3] + ((size_t)j * 128 + odk) * 256 + dvb * 16 + odv4);
#pragma unroll
            for (int i = 0; i < 4; ++i) tile[odk * 17 + odv4 + i] = v[i]; }
        __syncthreads();
        f32x4 s, f;
#pragma unroll
        for (int i = 0; i < 4; ++i) s[i] = tile[(dk4 + i) * 17 + dvl];
        const u32x2 kv = *(const u32x2*)(KVT + ((size_t)it * 256 + dv) * 128 + dk4); const f32x4 d = *(const f32x4*)(dec + (size_t)it * 128 + dk4);
        { u32x2 w; w.x = cvt_pk_bf16(s[0], s[1]); w.y = cvt_pk_bf16(s[2], s[3]); *(u32x2*)(KVT + ((size_t)it * 256 + dv) * 128 + dk4) = w; }
        f[0] = d[0] * s[0] + bf_lo(kv.x); f[1] = d[1] * s[1] + bf_hi(kv.x); f[2] = d[2] * s[2] + bf_lo(kv.y); f[3] = d[3] * s[3] + bf_hi(kv.y);
        __syncthreads();
#pragma unroll
        for (int i = 0; i < 4; ++i) tile[(dk4 + i) * 17 + dvl] = f[i];
        __syncthreads();
        { f32x4 o; o[0] = tile[odk * 17 + odv4]; o[1] = tile[odk * 17 + odv4 + 1]; o[2] = tile[odk * 17 + odv4 + 2]; o[3] = tile[odk * 17 + odv4 + 3];
            *(f32x4*)(P.out + OUT_GSS + ((size_t)j * 128 + odk) * 256 + dvb * 16 + odv4) = o; }
    }
}

__device__ __forceinline__ void gla_g3(const Params& P, unsigned char* lds) {
    const int tid = threadIdx.x, wid = tid >> 6, lane = tid & 63, fr = lane & 15, fq = lane >> 4;
    const bf16_t* qg = (const bf16_t*)(P.ws + O_Q); const bf16_t* kg = (const bf16_t*)(P.ws + O_K); const bf16_t* gg = (const bf16_t*)(P.ws + O_G);
    const bf16_t* vT = (const bf16_t*)(P.ws + O_VT); const bf16_t* SpT = (const bf16_t*)(P.ws + O_KVT); bf16_t* og = (bf16_t*)(P.ws + O_OG);
    const float* bsh = (const float*)(lds + L_BSH); bf16_t* qd = (bf16_t*)(lds + L_QD); bf16_t* kin = (bf16_t*)(lds + L_KIN); bf16_t* Psh = (bf16_t*)(lds + L_PSH); float* ssh = (float*)(lds + L_SSQ);
    bf16x8 sfp[4][2];
#define G3_LOAD_S(it_) do { _Pragma("unroll") for (int s_ = 0; s_ < 4; ++s_) _Pragma("unroll") for (int nt_ = 0; nt_ < 2; ++nt_) \
        sfp[s_][nt_] = *(const bf16x8*)(SpT + ((size_t)(it_) * 256 + 32 * wid + 16 * nt_ + fr) * 128 + 32 * s_ + 8 * fq); } while (0)
    if ((int)blockIdx.x < NITEM) G3_LOAD_S(blockIdx.x);
    for (int it = blockIdx.x; it < NITEM; it += gridDim.x) {
        const Item I = decode_item(it);
        compute_b(P, I, lds);
#pragma unroll
        for (int p = 0; p < 2; ++p) { const int idx = tid + p * NT, t = idx >> 4, c8 = (idx & 15) * 8; u32x4 qo = (u32x4){0u, 0u, 0u, 0u}, ko = (u32x4){0u, 0u, 0u, 0u};
            const int tcl = t < I.L ? t : I.L - 1; const u32x4 qw = *(const u32x4*)(qg + (size_t)(I.row0 + tcl) * KEYD + I.h * DK + c8), kw = *(const u32x4*)(kg + (size_t)(I.row0 + tcl) * KEYD + I.h * DK + c8);
            if (t < I.L) {
                const f32x4 b0 = *(const f32x4*)(bsh + t * 128 + c8), b1 = *(const f32x4*)(bsh + t * 128 + c8 + 4);
                float e[8], ei[8];
#pragma unroll
                for (int j = 0; j < 4; ++j) { e[j] = __expf(b0[j]); e[4 + j] = __expf(b1[j]); ei[j] = __expf(-b0[j]); ei[4 + j] = __expf(-b1[j]); }
                qo.x = cvt_pk_bf16(bf_lo(qw.x) * e[0], bf_hi(qw.x) * e[1]); qo.y = cvt_pk_bf16(bf_lo(qw.y) * e[2], bf_hi(qw.y) * e[3]); qo.z = cvt_pk_bf16(bf_lo(qw.z) * e[4], bf_hi(qw.z) * e[5]); qo.w = cvt_pk_bf16(bf_lo(qw.w) * e[6], bf_hi(qw.w) * e[7]);
                ko.x = cvt_pk_bf16(bf_lo(kw.x) * ei[0], bf_hi(kw.x) * ei[1]); ko.y = cvt_pk_bf16(bf_lo(kw.y) * ei[2], bf_hi(kw.y) * ei[3]); ko.z = cvt_pk_bf16(bf_lo(kw.z) * ei[4], bf_hi(kw.z) * ei[5]); ko.w = cvt_pk_bf16(bf_lo(kw.w) * ei[6], bf_hi(kw.w) * ei[7]); }
            *(u32x4*)(qd + t * 136 + c8) = qo; *(u32x4*)(kin + t * 136 + c8) = ko; }
        __syncthreads();
        { const int lt = wid >> 1;
#pragma unroll
            for (int q = 0; q < 2; ++q) { const int mt = 2 * (wid & 1) + q; f32x4 a4 = (f32x4){0.f, 0.f, 0.f, 0.f};
                if (mt <= lt) {
#pragma unroll
                    for (int s = 0; s < 4; ++s) { const bf16x8 a = *(const bf16x8*)(qd + (16 * lt + fr) * 136 + 32 * s + 8 * fq), b = *(const bf16x8*)(kin + (16 * mt + fr) * 136 + 32 * s + 8 * fq);
                        a4 = __builtin_amdgcn_mfma_f32_16x16x32_bf16(a, b, a4, 0, 0, 0); } }
                const int mcol = 16 * mt + fr;
#pragma unroll
                for (int j = 0; j < 4; ++j) { const int l = 16 * lt + 4 * fq + j; const float pv = (mcol <= l) ? a4[j] : 0.f; Psh[l * 72 + mcol] = (bf16_t)(cvt_pk_bf16(pv, 0.f) & 0xffffu); } } }
        __syncthreads();
        f32x4 acc[2][4];
#pragma unroll
        for (int nt = 0; nt < 2; ++nt)
#pragma unroll
            for (int lt = 0; lt < 4; ++lt) acc[nt][lt] = (f32x4){0.f, 0.f, 0.f, 0.f};
#pragma unroll
        for (int s = 0; s < 2; ++s) { const int t8 = 32 * s + 8 * fq;
            if (32 * s < I.L) {
                bf16x8 vf[2];
#pragma unroll
                for (int nt = 0; nt < 2; ++nt) { const int tc = t8 < I.L ? t8 : 0; vf[nt] = *(const bf16x8*)(vT + (size_t)(I.h * DV + 32 * wid + 16 * nt + fr) * MPAD + I.row0 + tc); if (t8 >= I.L) vf[nt] = (bf16x8){0, 0, 0, 0, 0, 0, 0, 0}; }
#pragma unroll
                for (int lt = 0; lt < 4; ++lt) { const bf16x8 pf = *(const bf16x8*)(Psh + (16 * lt + fr) * 72 + t8);
                    acc[0][lt] = __builtin_amdgcn_mfma_f32_16x16x32_bf16(vf[0], pf, acc[0][lt], 0, 0, 0); acc[1][lt] = __builtin_amdgcn_mfma_f32_16x16x32_bf16(vf[1], pf, acc[1][lt], 0, 0, 0); } } }
#pragma unroll
        for (int s = 0; s < 4; ++s) { const int k8 = 32 * s + 8 * fq;
#pragma unroll
            for (int lt = 0; lt < 4; ++lt) { const bf16x8 qf = *(const bf16x8*)(qd + (16 * lt + fr) * 136 + k8);
                acc[0][lt] = __builtin_amdgcn_mfma_f32_16x16x32_bf16(sfp[s][0], qf, acc[0][lt], 0, 0, 0); acc[1][lt] = __builtin_amdgcn_mfma_f32_16x16x32_bf16(sfp[s][1], qf, acc[1][lt], 0, 0, 0); } }
        if (it + (int)gridDim.x < NITEM) G3_LOAD_S(it + gridDim.x);
#pragma unroll
        for (int lt = 0; lt < 4; ++lt) { float ss = 0.f;
#pragma unroll
            for (int nt = 0; nt < 2; ++nt) ss += (acc[nt][lt][0] * acc[nt][lt][0] + acc[nt][lt][1] * acc[nt][lt][1]) + (acc[nt][lt][2] * acc[nt][lt][2] + acc[nt][lt][3] * acc[nt][lt][3]);
            ss += __shfl_xor(ss, 16); ss += __shfl_xor(ss, 32);
            if (fq == 0) ssh[wid * 64 + 16 * lt + fr] = ss; }
        u32x2 gwp[4][2];
#pragma unroll
        for (int lt = 0; lt < 4; ++lt)
#pragma unroll
            for (int nt = 0; nt < 2; ++nt) { const int l = 16 * lt + fr, lc = l < I.L ? l : I.L - 1;
                gwp[lt][nt] = *(const u32x2*)(gg + (size_t)(I.row0 + lc) * D + I.h * DV + 32 * wid + 16 * nt + 4 * fq); }
        __syncthreads();
#pragma unroll
        for (int lt = 0; lt < 4; ++lt) { const int l = 16 * lt + fr;
            if (l < I.L) { float tot = 0.f;
#pragma unroll
                for (int w8 = 0; w8 < 8; ++w8) tot += ssh[w8 * 64 + l];
                const float ro = rsqrtf(tot * (1.0f / 256.0f) + EPS);
#pragma unroll
                for (int nt = 0; nt < 2; ++nt) { const int dvh = 32 * wid + 16 * nt + 4 * fq; const size_t off = (size_t)(I.row0 + l) * D + I.h * DV + dvh;
                    const u32x2 gw = gwp[lt][nt]; const f32x4 nw = *(const f32x4*)(P.in[16] + dvh);
                    const float o0 = acc[nt][lt][0] * ro * nw[0] * siluf_(bf_lo(gw.x)), o1 = acc[nt][lt][1] * ro * nw[1] * siluf_(bf_hi(gw.x));
                    const float o2 = acc[nt][lt][2] * ro * nw[2] * siluf_(bf_lo(gw.y)), o3 = acc[nt][lt][3] * ro * nw[3] * siluf_(bf_hi(gw.y));
                    u32x2 w; w.x = cvt_pk_bf16(o0, o1); w.y = cvt_pk_bf16(o2, o3); *(u32x2*)(og + off) = w; } } }
        __syncthreads();
    }
}

__device__ __forceinline__ void final_norm(const Params& P, float* dst, int row_lo) {
    float* h = P.out + OUT_Y; const float* ssq = (const float*)(P.ws + O_SSQ) + 5 * M; const float* nf = P.in[9];
    constexpr int n4 = M * D / 4; const int stride = gridDim.x * NT;
    for (int i0 = row_lo * (D / 4) + blockIdx.x * NT + threadIdx.x; i0 < n4; i0 += 4 * stride) {
        f32x4 v[4];
#pragma unroll
        for (int j = 0; j < 4; ++j) { const int i = i0 + j * stride; v[j] = (f32x4){0.f, 0.f, 0.f, 0.f}; if (i < n4) v[j] = ((const f32x4*)h)[i]; }
#pragma unroll
        for (int j = 0; j < 4; ++j) { const int i = i0 + j * stride; if (i < n4) { const int r = i >> 8, c4 = (i & 255) * 4; const float ri = rinv_of(ssq[r]); const f32x4 g = *(const f32x4*)(nf + c4); ((f32x4*)dst)[i] = v[j] * ri * g; } }
    }
}
__device__ __forceinline__ void fused_final_tile(const Params& P, int pm, int pn, unsigned* cnt, unsigned char* lds_f) {
    const int tid = threadIdx.x;
    asm volatile("s_waitcnt vmcnt(0)" ::: "memory");
    __syncthreads();
    if (tid == 0) {
        __hip_atomic_fetch_add(cnt + 16 * pm, 1u, __ATOMIC_RELAXED, __HIP_MEMORY_SCOPE_AGENT);
        unsigned sp = 0;
        while (__hip_atomic_load(cnt + 16 * pm, __ATOMIC_RELAXED, __HIP_MEMORY_SCOPE_AGENT) < 4u) { __builtin_amdgcn_s_sleep(2); if (++sp > (1u << 22)) break; }
    }
    __syncthreads();
    float* h = P.out + OUT_Y; float* ssq = (float*)(P.ws + O_SSQ) + 5 * M; const float* nf = P.in[9];
    float* rs = (float*)lds_f;
    if (tid < 256) rs[tid] = rinv_of(__hip_atomic_load(ssq + pm * 256 + tid, __ATOMIC_RELAXED, __HIP_MEMORY_SCOPE_AGENT));
    __syncthreads();
    const int c4 = (tid & 63) * 4; const f32x4 g = *(const f32x4*)(nf + pn * 256 + c4);
    for (int i0 = 0; i0 < 32; i0 += 8) {
        f32x4 v[8];
#pragma unroll
        for (int j = 0; j < 8; ++j) { const int row = (i0 + j) * 8 + (tid >> 6); v[j] = *(const f32x4*)(h + (size_t)(pm * 256 + row) * D + pn * 256 + c4); }
#pragma unroll
        for (int j = 0; j < 8; ++j) { const int row = (i0 + j) * 8 + (tid >> 6); *(f32x4*)(h + (size_t)(pm * 256 + row) * D + pn * 256 + c4) = v[j] * rs[row] * g; } }
    __syncthreads();
}

__device__ __forceinline__ void fused_final_sample(const Params& P, int rt, int ct, unsigned* cnt) {
    const int tid = threadIdx.x;
    asm volatile("s_waitcnt vmcnt(0)" ::: "memory");
    __syncthreads();
    if (tid == 0) {
        __hip_atomic_fetch_add(cnt + 16 * rt, 1u, __ATOMIC_RELAXED, __HIP_MEMORY_SCOPE_AGENT);
        unsigned sp = 0;
        while (__hip_atomic_load(cnt + 16 * rt, __ATOMIC_RELAXED, __HIP_MEMORY_SCOPE_AGENT) < 32u) { __builtin_amdgcn_s_sleep(2); if (++sp > (1u << 22)) break; }
    }
    __syncthreads();
    if (tid < 256) { float* h = P.out + OUT_Y; float* ssq = (float*)(P.ws + O_SSQ) + 5 * M; const float* nf = P.in[9];
        const int r = MP_ROWS + 32 * rt + (tid >> 3), c = 32 * ct + (tid & 7) * 4;
        const float ri = rinv_of(__hip_atomic_load(ssq + r, __ATOMIC_RELAXED, __HIP_MEMORY_SCOPE_AGENT));
        float* hp = h + (size_t)r * D + c; f32x4 v = *(const f32x4*)hp; const f32x4 g = *(const f32x4*)(nf + c); *(f32x4*)hp = v * ri * g; }
}

__global__ void __launch_bounds__(NT, 2) fwd_kernel(Params P) {
    extern __shared__ __attribute__((aligned(16))) unsigned char lds[];
    cg::grid_group grid = cg::this_grid();
    LAS unsigned char* ldsl = (LAS unsigned char*)lds;
    unsigned char* ws = P.ws;
    const int G = gridDim.x, bx = blockIdx.x;
    float* h = P.out + OUT_Y;
    bf16_t* hbA = (bf16_t*)(ws + O_HBA); bf16_t* hbB = (bf16_t*)(ws + O_HBB);
    float* ssq = (float*)(ws + O_SSQ);
    bf16_t* act = (bf16_t*)(ws + O_ACT); bf16_t* pp = (bf16_t*)(ws + O_PP);
    const int lo = P.ph_lo, hi = (gridDim.x == 256 && P.ph_hi == 14) ? 13 : P.ph_hi;
#define STAGGER() do { const int ns_ = (bx >> 3) & 3; for (int i_ = 0; i_ < ns_; ++i_) __builtin_amdgcn_s_sleep(31); } while (0)
    if (threadIdx.x < 4) ((unsigned*)(lds + LDS_MAIN))[threadIdx.x] = 0u;
    __syncthreads();
    const XcdBarrier xbar = xcd_barrier_post((unsigned*)(ws + O_BAR), (volatile LAS unsigned*)(ldsl + LDS_MAIN));
    if (lo > 1000) grid.sync();
#define GRID_SYNC() xcd_barrier(xbar)
#ifndef DUPMASK
#define DUPMASK 0
#endif
#define DUP(k) (((DUPMASK) >> (k)) & 1)
#define PHASE(k, ...) if (EN(k) && lo <= (k) && (k) < hi) { constexpr bool dup_ = false; (void)dup_; __VA_ARGS__ if ((k) + 1 < hi) GRID_SYNC(); } if (DUP(k) && lo <= (k) && (k) < hi) { constexpr bool dup_ = true; (void)dup_; __VA_ARGS__ GRID_SYNC(); }
    PHASE(0,
        pool_diffs(P, (float*)lds);
        __syncthreads();
        convert_p(P, 0, (bf16_t*)(ws + O_PB0));
        prep_weights(P, (float*)lds);
    )
    PHASE(1,
        { pg8::Gemm g{(const bf16_t*)(ws + O_DM), (const bf16_t*)(ws + O_WP), D, 256, 256, 256}; pg8::StaticOrder S; S.init(64, 4, G, bx);
          EpiPool E{P.in[0], P.in[1], h, hbA, P.in[11], P.in[12], ssq + (dup_ ? 6 : 0) * M}; pg8::gemm_phase(ldsl, g, S, E);
          small_gemm(lds, g.A, D, g.Bt, 256, 256, 32, 256, E); }
    )
    PHASE(2,
        { pg8::Gemm g{hbA, (const bf16_t*)(ws + O_WGU), D, D, D, 0}; pg8::StaticOrder S; S.init(65, 22, G, bx);
          EpiGU E{act, ssq + 0 * M}; pg8::gemm_phase(ldsl, g, S, E); }
        if (G == 256 ? bx >= 150 : true) { const int gs = G == 256 ? 106 : G, gc = G == 256 ? bx - 150 : bx;
          pg8::Gemm g{(const bf16_t*)(ws + O_PB0), (const bf16_t*)(ws + O_WPP), PLE, PLE, PLE, 0}; pg8::StaticOrder S; S.init(64, 4, gs, gc);
          EpiBf E{pp, D}; pg8::gemm_phase(ldsl, g, S, E);
          small_gemm(lds, g.A, PLE, g.Bt, PLE, PLE, 32, 0, E, gc, gs); }
    )
    PHASE(3,
        pg8::Gemm g{act, (const bf16_t*)(ws + O_WD), DFF, DFF, DFF, 0}; pg8::StaticOrder S; S.init(64, 4, G, bx);
        EpiRes E{h, hbB, ssq + (dup_ ? 6 : 1) * M, dup_ ? 0.f : 1.f}; pg8::gemm_phase(ldsl, g, S, E);
        small_gemm(lds, g.A, DFF, g.Bt, DFF, DFF, 32, 0, E);
    )
    PHASE(4,
        pg8::Gemm g{hbB, (const bf16_t*)(ws + O_WPG), D, D, D, 0}; pg8::StaticOrder S; S.init(64, 4, G, bx);
        EpiPle E{h, hbA, pp, ssq + 1 * M, ssq + (dup_ ? 6 : 2) * M, dup_ ? 0.f : 1.f}; pg8::gemm_phase(ldsl, g, S, E);
        small_gemm(lds, g.A, D, g.Bt, D, D, 32, 0, E);
    )
    PHASE(5,
        gr_pass(hbA, (const bf16_t*)(ws + O_WGR), ssq + 2 * M, (float*)(ws + O_GR));
        __syncthreads();
        { pg8::Gemm g{hbA, (const bf16_t*)(ws + O_WIN), D, D, D, 0}; pg8::StaticOrder S; S.init(64, 8, G, bx);
          EpiQKG E{(bf16_t*)(ws + O_Q), (bf16_t*)(ws + O_K), (bf16_t*)(ws + O_G), ssq + 2 * M}; pg8::gemm_phase(ldsl, g, S, E);
          small_gemm(lds, g.A, D, g.Bt, D, D, 64, 0, E); }
        { pg8::Gemm g{(const bf16_t*)(ws + O_WIN) + (size_t)2048 * 1024, hbA, D, D, D, 0}; pg8::StaticOrder S; S.init(4, 64, G, bx);
          EpiVT E{(bf16_t*)(ws + O_VT), ssq + 2 * M}; pg8::gemm_phase(ldsl, g, S, E);
          small_gemm(lds, hbA, D, g.A, D, D, 32, 0, E); }
    )
    PHASE(6, gla_g1(P, lds); if (!dup_ && G == 256 && bx >= 64) { __syncthreads(); for (int k = bx - 64; k < N_DEFER; k += 384) weight_tile(P, defer_tile(k), (float*)lds); } )
    PHASE(7, gla_g2(P, lds); )
    PHASE(8, gla_g3(P, lds); if (!dup_ && G == 256 && bx >= 64) { __syncthreads(); for (int k = 192 + bx - 64; k < N_DEFER; k += 384) weight_tile(P, defer_tile(k), (float*)lds); } )
    PHASE(9,
        pg8::Gemm g{(const bf16_t*)(ws + O_OG), (const bf16_t*)(ws + O_WO), D, D, D, 0}; pg8::StaticOrder S; S.init(64, 4, G, bx);
        EpiRes E{h, hbB, ssq + (dup_ ? 6 : 3) * M, dup_ ? 0.f : 1.f}; pg8::gemm_phase(ldsl, g, S, E);
        small_gemm(lds, g.A, D, g.Bt, D, D, 32, 0, E);
        convert_p(P, 1, (bf16_t*)(ws + O_PB1));
    )
    PHASE(10,
        { pg8::Gemm g{hbB, (const bf16_t*)(ws + O_WGU) + (size_t)5632 * 1024, D, D, D, 0}; pg8::StaticOrder S; S.init(65, 22, G, bx);
          EpiGU E{act, ssq + 3 * M}; pg8::gemm_phase(ldsl, g, S, E); }
        if (G == 256 ? bx >= 150 : true) { const int gs = G == 256 ? 106 : G, gc = G == 256 ? bx - 150 : bx;
          pg8::Gemm g{(const bf16_t*)(ws + O_PB1), (const bf16_t*)(ws + O_WPP) + (size_t)1024 * 256, PLE, PLE, PLE, 0}; pg8::StaticOrder S; S.init(64, 4, gs, gc);
          EpiBf E{pp, D}; pg8::gemm_phase(ldsl, g, S, E);
          small_gemm(lds, g.A, PLE, g.Bt, PLE, PLE, 32, 0, E, gc, gs); }
    )
    PHASE(11,
        { pg8::Gemm g{act, (const bf16_t*)(ws + O_WD) + (size_t)1024 * 2816, DFF, DFF, DFF, 0}; pg8::StaticOrder S; S.init(64, 4, G, bx);
          EpiRes E{h, hbA, ssq + (dup_ ? 6 : 4) * M, dup_ ? 0.f : 1.f}; pg8::gemm_phase(ldsl, g, S, E);
          small_gemm(lds, g.A, DFF, g.Bt, DFF, DFF, 32, 0, E); }
    )
    PHASE(12,
        pg8::Gemm g{hbA, (const bf16_t*)(ws + O_WPG) + (size_t)1024 * 1024, D, D, D, 0}; pg8::StaticOrder S; S.init(64, 4, G, bx);
        EpiPle E{h, (bf16_t*)nullptr, pp, ssq + 4 * M, ssq + (dup_ ? 6 : 5) * M, dup_ ? 0.f : 1.f}; pg8::gemm_phase(ldsl, g, S, E);
        if (!dup_ && G == 256) { pg8::Unit u; if (S.next(0, u)) fused_final_tile(P, u.pm, u.pn, (unsigned*)(ws + O_BAR) + 4096, lds); }
        small_gemm(lds, g.A, D, g.Bt, D, D, 32, 0, E);
        if (!dup_ && G == 256) fused_final_sample(P, bx & 7, bx >> 3, (unsigned*)(ws + O_BAR) + 4096 + 16 * 64);
    )
#ifdef EXTRA_SYNCS
    for (int i_ = 0; i_ < EXTRA_SYNCS; ++i_) GRID_SYNC();
#endif
    if (G != 256) { PHASE(13, final_norm(P, dup_ ? (float*)(ws + O_ACT) : P.out + OUT_Y, 0); ) }
}

extern "C" void kernel_launch(void* const* d_in, const int* in_sizes, int n_in, void* d_out, int out_size, void* d_ws, size_t ws_size, hipStream_t stream) {
    static int grid_blocks = 0;
    if (!grid_blocks) {
        int dev = 0, cus = 0, per_cu = 0;
        hipGetDevice(&dev);
        hipDeviceGetAttribute(&cus, hipDeviceAttributeMultiprocessorCount, dev);
        if (hipFuncSetAttribute((const void*)fwd_kernel, hipFuncAttributeMaxDynamicSharedMemorySize, LDS_BYTES) != hipSuccess) fprintf(stderr, "hipFuncSetAttribute failed\n");
        if (hipOccupancyMaxActiveBlocksPerMultiprocessor(&per_cu, (const void*)fwd_kernel, NT, LDS_BYTES) != hipSuccess || per_cu < 1) { fprintf(stderr, "occupancy query: %d\n", per_cu); per_cu = 1; }
        (void)hipGetLastError();
        grid_blocks = cus;
        if (ws_size < WS_NEED) fprintf(stderr, "workspace too small: %zu < %zu\n", ws_size, (size_t)WS_NEED);
    }
    Params p{};
    for (int i = 0; i < 23; ++i) p.in[i] = (const float*)d_in[i];
    p.out = (float*)d_out; p.ws = (unsigned char*)d_ws; p.ph_lo = 0; p.ph_hi = 14;
    (void)hipMemsetAsync((unsigned char*)d_ws + O_BAR, 0, BAR_BYTES, stream);
    void* args[] = {&p};
    hipError_t e = hipLaunchCooperativeKernel((const void*)fwd_kernel, dim3(grid_blocks), dim3(NT), args, LDS_BYTES, stream);
    if (e != hipSuccess) fprintf(stderr, "cooperative launch failed: %s (grid %d)\n", hipGetErrorString(e), grid_blocks);
}
```
